# Optimizing an MI355X kernel written in HIP

```python
import math
import jax
import jax.numpy as jnp
from jax import lax
import numpy as np

D_MODEL = 1024
BATCH = 32
SEQ = 2048
DEPTH = 1

CTX_LEN = 256
GRID_W = 64
SSD_D_INNER = 2 * D_MODEL
SSD_HEADDIM = 64
SSD_HEADS = SSD_D_INNER // SSD_HEADDIM
SSD_GROUPS = 8
SSD_HPG = SSD_HEADS // SSD_GROUPS
SSD_STATE = 128
SSD_CHUNK = 128
CONV_K = 4
CONV_LEFT = 2
LRU_WIDTH = D_MODEL
LRU_BLOCKS = 8
LRU_BLOCK_W = LRU_WIDTH // LRU_BLOCKS
LRU_C = 8.0
MLP_HIDDEN = 4 * D_MODEL
N_BRANCH = 2
N_MOD = 6
DEEPNORM_ALPHA = (2 * DEPTH) ** 0.25
DEEPNORM_BETA = (8 * DEPTH) ** -0.25
LN_EPS = 1e-6
RMS_EPS = 1e-5

SSD_BC_W = SSD_GROUPS * SSD_STATE
SSD_XB = SSD_D_INNER + SSD_BC_W
SSD_XBC = SSD_D_INNER + 2 * SSD_BC_W
SSD_DT = 2 * SSD_HEADS
O_DT = SSD_XB
O_LRU = O_DT + SSD_DT
STATE_COLS = O_LRU + LRU_WIDTH
O_C = STATE_COLS
O_Z = O_C + SSD_BC_W
O_LRU_GATE = O_Z + SSD_D_INNER
O_MERGE = O_LRU_GATE + LRU_WIDTH
IN_COLS = O_MERGE + N_BRANCH * D_MODEL

kernel_name = 'hybrid_ssd_rglru_dit_block'


def layer_norm(x, g=None, b=None):
    xf = x.astype(jnp.float32)
    mu = jnp.mean(xf, axis=-1, keepdims=True)
    var = jnp.mean(jnp.square(xf - mu), axis=-1, keepdims=True)
    y = (xf - mu) * lax.rsqrt(var + LN_EPS)
    if g is not None:
        y = y * g.astype(jnp.float32) + b.astype(jnp.float32)
    return y.astype(x.dtype)


def modulation(cvec, w_mod, b_mod, n_chunks):
    m = jax.nn.silu(cvec) @ w_mod[:, :n_chunks * D_MODEL] + b_mod[:n_chunks * D_MODEL]
    return jnp.split(m, n_chunks, axis=-1)


def modulate(x, shift, scale):
    return layer_norm(x) * (1.0 + scale) + shift


def short_conv(u, w, b, rows):
    bsz, t, ch = u.shape
    v = u if rows is None else u.reshape(bsz, rows, GRID_W, ch)
    n = v.shape[-2]
    pad = [(0, 0)] * (v.ndim - 2) + [(CONV_LEFT, CONV_K - 1 - CONV_LEFT), (0, 0)]
    vp = jnp.pad(v, pad)
    out = b
    for k in range(CONV_K):
        out = out + vp[..., k:k + n, :] * w[k]
    return out.reshape(bsz, t, ch)


def ssd_chunked(xh, dt, a_neg, bm, cm, h0):
    bsz, t = xh.shape[:2]
    nc = t // SSD_CHUNK
    xc = (xh.astype(jnp.float32) * dt[..., None]).reshape(bsz, nc, SSD_CHUNK, SSD_GROUPS, SSD_HPG, SSD_HEADDIM)
    cum = jnp.cumsum((dt * a_neg).reshape(bsz, nc, SSD_CHUNK, SSD_GROUPS, SSD_HPG), axis=2)
    bc = bm.astype(jnp.float32).reshape(bsz, nc, SSD_CHUNK, SSD_GROUPS, SSD_STATE)
    to_end = jnp.exp(cum[:, :, -1:] - cum)
    states = jnp.einsum('bcjgn,bcjgh,bcjghp->bcghpn', bc, to_end, xc)
    chunk_decay = jnp.exp(cum[:, :, -1])

    def step(h, inp):
        dec, st = inp
        return dec[..., None, None] * h + st, h

    h_fin, h_start = lax.scan(step, h0, (jnp.moveaxis(chunk_decay, 1, 0), jnp.moveaxis(states, 1, 0)))
    if cm is None:
        return None, h_fin
    h_start = jnp.moveaxis(h_start, 0, 1)
    cc = cm.astype(jnp.float32).reshape(bsz, nc, SSD_CHUNK, SSD_GROUPS, SSD_STATE)
    seg = cum[:, :, :, None] - cum[:, :, None, :]
    lower = jnp.tril(jnp.ones((SSD_CHUNK, SSD_CHUNK), dtype=bool))[:, :, None, None]
    decay = jnp.exp(jnp.where(lower, seg, -jnp.inf))
    cb = jnp.einsum('bcign,bcjgn->bcijg', cc, bc)
    y = (jnp.einsum('bcijg,bcijgh,bcjghp->bcighp', cb, decay, xc)
         + jnp.einsum('bcign,bcigh,bcghpn->bcighp', cc, jnp.exp(cum), h_start))
    return y.reshape(bsz, t, SSD_HEADS, SSD_HEADDIM), h_fin


def gated_rmsnorm(y, z, w):
    u = (y * jax.nn.silu(z)).astype(jnp.float32)
    ug = u.reshape(*u.shape[:-1], SSD_GROUPS, -1)
    ug = ug * lax.rsqrt(jnp.mean(jnp.square(ug), axis=-1, keepdims=True) + RMS_EPS)
    return (ug.reshape(u.shape) * w.astype(jnp.float32)).astype(y.dtype)


def ssd_branch(xb_raw, c_raw, dt_raw, p, h0_f, h0_b, rows):
    bsz, t, _ = xb_raw.shape
    xb = jax.nn.silu(short_conv(xb_raw, p['ssd_conv_w'][:, :SSD_XB], p['ssd_conv_b'][:SSD_XB], rows))
    xh = xb[..., :SSD_D_INNER].reshape(bsz, t, SSD_HEADS, SSD_HEADDIM)
    bm = xb[..., SSD_D_INNER:].reshape(bsz, t, SSD_GROUPS, SSD_STATE)
    cm = None
    if c_raw is not None:
        cm = jax.nn.silu(short_conv(c_raw, p['ssd_conv_w'][:, SSD_XB:], p['ssd_conv_b'][SSD_XB:], rows))
        cm = cm.reshape(bsz, t, SSD_GROUPS, SSD_STATE)
    dt = jax.nn.softplus(dt_raw.astype(jnp.float32).reshape(bsz, t, 2, SSD_HEADS) + p['ssd_dt_bias'])
    a_neg = -jnp.exp(p['ssd_a_log'].astype(jnp.float32))
    flip = lambda u: None if u is None else jnp.flip(u, axis=1)
    y_f, s_f = ssd_chunked(xh, dt[:, :, 0], a_neg[0], bm, cm, h0_f)
    y_b, s_b = ssd_chunked(flip(xh), flip(dt[:, :, 1]), a_neg[1], flip(bm), flip(cm), h0_b)
    if c_raw is None:
        return None, s_f, s_b
    y = y_f + flip(y_b) + p['ssd_d'][:, None] * xh
    return y.reshape(bsz, t, SSD_D_INNER).astype(xb_raw.dtype), s_f, s_b


def lru_combine(e1, e2):
    a1, b1 = e1
    a2, b2 = e2
    return a1 * a2, a2 * b1 + b2


def rglru(u, wa, ba, wi, bi, lam, h0, reverse):
    bsz, t, w = u.shape
    uf = u.astype(jnp.float32)
    ub = uf.reshape(bsz, t, LRU_BLOCKS, LRU_BLOCK_W)
    r = jax.nn.sigmoid(jnp.einsum('btkc,kcd->btkd', ub, wa).reshape(bsz, t, w) + ba)
    i = jax.nn.sigmoid(jnp.einsum('btkc,kcd->btkd', ub, wi).reshape(bsz, t, w) + bi)
    log_a = -LRU_C * r * jax.nn.softplus(-lam)
    a = jnp.exp(log_a)
    b_in = jnp.sqrt(-jnp.expm1(2.0 * log_a)) * (i * uf)
    edge = t - 1 if reverse else 0
    b_in = b_in.at[:, edge].add(a[:, edge] * h0)
    _, h = lax.associative_scan(lru_combine, (a, b_in), reverse=reverse, axis=1)
    return h, h[:, 0 if reverse else t - 1]


def lru_branch(u_raw, p, h0_f, h0_b, rows, need_y):
    u = short_conv(u_raw, p['lru_conv_w'], p['lru_conv_b'], rows)
    h_f, s_f = rglru(u, p['lru_wa'][0], p['lru_ba'][0], p['lru_wi'][0], p['lru_bi'][0], p['lru_lambda'][0], h0_f, False)
    h_b, s_b = rglru(u, p['lru_wa'][1], p['lru_ba'][1], p['lru_wi'][1], p['lru_bi'][1], p['lru_lambda'][1], h0_b, True)
    if not need_y:
        return None, s_f, s_b
    return (h_f + h_b).astype(u_raw.dtype), s_f, s_b


def token_mixer(h, p, init, rows, need_out):
    cols = IN_COLS if need_out else STATE_COLS
    proj = h @ p['w_in'][:, :cols]
    xb_raw = proj[..., :O_DT]
    dt_raw = proj[..., O_DT:O_LRU]
    lru_raw = proj[..., O_LRU:STATE_COLS]
    c_raw = proj[..., O_C:O_Z] if need_out else None
    y_ssd, s_f, s_b = ssd_branch(xb_raw, c_raw, dt_raw, p, init[0], init[1], rows)
    y_lru, l_f, l_b = lru_branch(lru_raw, p, init[2], init[3], rows, need_out)
    states = (s_f, s_b, l_f, l_b)
    if not need_out:
        return None, states
    z = proj[..., O_Z:O_LRU_GATE]
    lru_gate = proj[..., O_LRU_GATE:O_MERGE]
    gates = jax.nn.sigmoid(proj[..., O_MERGE:] + p['b_gate'])
    g_ssd, g_lru = jnp.split(gates, N_BRANCH, axis=-1)
    br_ssd = gated_rmsnorm(y_ssd, z, p['ssd_norm_w']) @ p['w_br_ssd']
    br_lru = (y_lru * jax.nn.gelu(lru_gate)) @ p['w_br_lru']
    return (g_ssd * br_ssd + g_lru * br_lru) @ p['w_out'], states


def sq_relu_mlp(h, p):
    return jnp.square(jax.nn.relu(h @ p['w_mlp1'] + p['b_mlp1'])) @ p['w_mlp2'] + p['b_mlp2']


def setup_inputs(seed: int = 0) -> dict:
    key = jax.random.key(seed)
    ks = jax.random.split(key, 40)
    f32 = jnp.float32

    def nrm(k, shape, fan_in, gain=1.0):
        return jax.random.normal(k, shape, f32) * (gain * fan_in ** -0.5)

    def small(k, shape):
        return 0.01 * jax.random.normal(k, shape, f32)

    dt0 = jnp.exp(jax.random.uniform(ks[8], (DEPTH, 2, SSD_HEADS), f32, minval=math.log(1e-3), maxval=math.log(1e-1)))
    a_pow = jax.random.uniform(ks[17], (DEPTH, 2, LRU_WIDTH), f32, minval=0.9, maxval=0.999)
    a_base = a_pow ** (1.0 / LRU_C)
    return {
        'x': jax.random.normal(ks[0], (BATCH, SEQ, D_MODEL), f32),
        'c': jax.random.normal(ks[1], (BATCH, D_MODEL), f32),
        'ctx': jax.random.normal(ks[2], (BATCH, CTX_LEN, D_MODEL), f32),
        'c_ctx': jax.random.normal(ks[3], (D_MODEL,), f32),
        'w_mod': nrm(ks[4], (DEPTH, D_MODEL, N_MOD * D_MODEL), D_MODEL),
        'b_mod': small(ks[5], (DEPTH, N_MOD * D_MODEL)),
        'w_in': nrm(ks[6], (DEPTH, D_MODEL, IN_COLS), D_MODEL),
        'b_gate': small(ks[7], (DEPTH, N_BRANCH * D_MODEL)),
        'ssd_conv_w': nrm(ks[9], (DEPTH, CONV_K, SSD_XBC), CONV_K),
        'ssd_conv_b': small(ks[10], (DEPTH, SSD_XBC)),
        'ssd_dt_bias': dt0 + jnp.log(-jnp.expm1(-dt0)),
        'ssd_a_log': jnp.log(jax.random.uniform(ks[11], (DEPTH, 2, SSD_HEADS), f32, minval=1.0, maxval=16.0)),
        'ssd_d': 1.0 + small(ks[12], (DEPTH, SSD_HEADS)),
        'ssd_norm_w': 1.0 + small(ks[13], (DEPTH, SSD_D_INNER)),
        'lru_conv_w': nrm(ks[14], (DEPTH, CONV_K, LRU_WIDTH), CONV_K),
        'lru_conv_b': small(ks[15], (DEPTH, LRU_WIDTH)),
        'lru_wa': nrm(ks[16], (DEPTH, 2, LRU_BLOCKS, LRU_BLOCK_W, LRU_BLOCK_W), LRU_BLOCK_W),
        'lru_ba': small(ks[18], (DEPTH, 2, LRU_WIDTH)),
        'lru_wi': nrm(ks[19], (DEPTH, 2, LRU_BLOCKS, LRU_BLOCK_W, LRU_BLOCK_W), LRU_BLOCK_W),
        'lru_bi': small(ks[20], (DEPTH, 2, LRU_WIDTH)),
        'lru_lambda': jnp.log(a_base) - jnp.log1p(-a_base),
        'w_br_ssd': nrm(ks[21], (DEPTH, SSD_D_INNER, D_MODEL), SSD_D_INNER, DEEPNORM_BETA),
        'w_br_lru': nrm(ks[22], (DEPTH, LRU_WIDTH, D_MODEL), LRU_WIDTH, DEEPNORM_BETA),
        'w_out': nrm(ks[23], (DEPTH, D_MODEL, D_MODEL), D_MODEL, DEEPNORM_BETA),
        'ln1_g': 1.0 + small(ks[24], (DEPTH, D_MODEL)),
        'ln1_b': small(ks[25], (DEPTH, D_MODEL)),
        'w_mlp1': nrm(ks[26], (DEPTH, D_MODEL, MLP_HIDDEN), D_MODEL),
        'b_mlp1': small(ks[27], (DEPTH, MLP_HIDDEN)),
        'w_mlp2': nrm(ks[28], (DEPTH, MLP_HIDDEN, D_MODEL), MLP_HIDDEN, DEEPNORM_BETA),
        'b_mlp2': small(ks[29], (DEPTH, D_MODEL)),
        'ln2_g': 1.0 + small(ks[30], (DEPTH, D_MODEL)),
        'ln2_b': small(ks[31], (DEPTH, D_MODEL)),
    }


def reference(x, c, ctx, c_ctx, w_mod, b_mod, w_in, b_gate, ssd_conv_w, ssd_conv_b, ssd_dt_bias,
              ssd_a_log, ssd_d, ssd_norm_w, lru_conv_w, lru_conv_b, lru_wa, lru_ba, lru_wi, lru_bi,
              lru_lambda, w_br_ssd, w_br_lru, w_out, ln1_g, ln1_b, w_mlp1, b_mlp1, w_mlp2, b_mlp2,
              ln2_g, ln2_b):
    bsz = x.shape[0]
    rows = x.shape[1] // GRID_W
    for l in range(DEPTH):
        p = dict(w_in=w_in[l], b_gate=b_gate[l], ssd_conv_w=ssd_conv_w[l], ssd_conv_b=ssd_conv_b[l],
                 ssd_dt_bias=ssd_dt_bias[l], ssd_a_log=ssd_a_log[l], ssd_d=ssd_d[l], ssd_norm_w=ssd_norm_w[l],
                 lru_conv_w=lru_conv_w[l], lru_conv_b=lru_conv_b[l], lru_wa=lru_wa[l], lru_ba=lru_ba[l],
                 lru_wi=lru_wi[l], lru_bi=lru_bi[l], lru_lambda=lru_lambda[l], w_br_ssd=w_br_ssd[l],
                 w_br_lru=w_br_lru[l], w_out=w_out[l], w_mlp1=w_mlp1[l], b_mlp1=b_mlp1[l],
                 w_mlp2=w_mlp2[l], b_mlp2=b_mlp2[l])
        last = l == DEPTH - 1
        zero_ssd = jnp.zeros((bsz, SSD_GROUPS, SSD_HPG, SSD_HEADDIM, SSD_STATE), jnp.float32)
        zero_lru = jnp.zeros((bsz, LRU_WIDTH), jnp.float32)
        mc = modulation(c_ctx, w_mod[l], b_mod[l], 2 if last else N_MOD)
        ctx_mix, ctx_states = token_mixer(modulate(ctx, mc[0], mc[1]), p,
                                          (zero_ssd, zero_ssd, zero_lru, zero_lru), None, not last)
        mx = [m[:, None, :] for m in modulation(c, w_mod[l], b_mod[l], N_MOD)]
        x_mix, _ = token_mixer(modulate(x, mx[0], mx[1]), p, ctx_states, rows, True)
        x = layer_norm(DEEPNORM_ALPHA * x + mx[2] * x_mix, ln1_g[l], ln1_b[l])
        x = layer_norm(DEEPNORM_ALPHA * x + mx[5] * sq_relu_mlp(modulate(x, mx[3], mx[4]), p), ln2_g[l], ln2_b[l])
        if not last:
            ctx = layer_norm(DEEPNORM_ALPHA * ctx + mc[2] * ctx_mix, ln1_g[l], ln1_b[l])
            ctx = layer_norm(DEEPNORM_ALPHA * ctx + mc[5] * sq_relu_mlp(modulate(ctx, mc[3], mc[4]), p),
                             ln2_g[l], ln2_b[l])
    return x
```

```cpp
#include <hip/hip_runtime.h>
#include <hip/hip_cooperative_groups.h>
#include <cstdio>
namespace cg = cooperative_groups;
namespace pg8 {
#define PG8_LAS __attribute__((address_space(3)))
typedef unsigned short bf16_t;
typedef short bf16x8 __attribute__((ext_vector_type(8)));
typedef float f32x4 __attribute__((ext_vector_type(4)));
typedef unsigned u32x4 __attribute__((ext_vector_type(4)));
constexpr int BM = 256, BK = 64, HALF = 128, HTB = HALF * BK * 2  , STAGE_BYTES = 8 * HTB, NXCD = 8, WGM = 8;
__host__ __device__ __forceinline__ int lds_byte(int r, int c) { const int st = (r >> 4) * 2 + (c >> 5), rr = r & 15, cc = c & 31, ob = rr * 64 + cc * 2; return st * 1024 + (ob ^ (((ob >> 9) & 1) << 5)); }
__host__ __device__ __forceinline__ void stage_rc(int b, int& R, int& C) { const int st = b / 1024, sb = b % 1024, swz = sb ^ (((sb >> 9) & 1) << 5); R = (st >> 1) * 16 + swz / 64; C = (st & 1) * 32 + (swz % 64) / 2; }
__host__ __device__ __forceinline__ int perm32(int rho) { const int n = rho >> 4, i = rho & 15; return 8 * (i >> 2) + 4 * n + (i & 3); }

struct Unit { int pm, pn; };
struct Gemm { const bf16_t* A; const bf16_t* Bt; int M, N, K; };
struct StaticOrder {
    int nM, nN, nwg, G, c;
    __host__ __device__ void init(int M, int N, int G_, int c_) { nM = M / BM; nN = N / BM; nwg = nM * nN; G = G_; c = c_; }
    __host__ __device__ bool next(int i, Unit& u) const {
        const long L = (long)i * G + c; if (L >= nwg) return false;
        int wgid = (int)L; { const int q = nwg / NXCD, r = nwg % NXCD, xcd = wgid % NXCD, off = wgid / NXCD; wgid = (xcd < r ? xcd * (q + 1) : r * (q + 1) + (xcd - r) * q) + off; }
        const int nig = WGM * nN, gid = wgid / nig, fm = gid * WGM, gsz = (nM - fm) < WGM ? (nM - fm) : WGM;
        u.pm = fm + ((wgid % nig) % gsz); u.pn = (wgid % nig) / gsz; return true;
    }
    __device__ __forceinline__ void a_ready(const Unit&) const {}
    __device__ __forceinline__ void done(const Unit&) const {}
};
__device__ __forceinline__ unsigned cvt_pk_bf16(float lo, float hi) { unsigned r; asm volatile("s_nop 0\n\tv_cvt_pk_bf16_f32 %0, %1, %2\n\ts_nop 1" : "=v"(r) : "v"(lo), "v"(hi)); return r; }
template <class Epi, class Sched>
__device__ __forceinline__ void gemm_phase(PG8_LAS unsigned char* lds, const Gemm g, const Sched& S, const Epi& E, int tid_in) {
    int tid_ = tid_in; asm volatile("" : "+v"(tid_));
    const int tid = tid_, wid = __builtin_amdgcn_readfirstlane(tid >> 6), lane = tid & 63, wr = wid >> 2, wc = wid & 3, fr = lane & 15, fq = lane >> 4;
    const int K = g.K, nt = K / BK;
    unsigned voffA[2], voffB[2];
#pragma unroll
    for (int i = 0; i < 2; ++i) { int R, C; stage_rc(tid * 16 + i * 8192, R, C); const int Rb = Epi::PERM ? ((R & ~31) + perm32(R & 31)) : R;
        voffA[i] = (unsigned)(R * K + C) * 2u; voffB[i] = (unsigned)(Rb * K + C) * 2u; }
    const size_t kstep = (size_t)(BK * 2);
    const size_t hstep = (size_t)HALF * K * 2;
    const size_t tstep = 2 * hstep;
    const unsigned ldsw = (unsigned)wid * 1024u;
    const int aoff = lds_byte(wr * 64 + fr, fq * 8), boff = lds_byte(wc * 32 + fr, fq * 8);
#define PG8_SA(b, h) (((b) * 2 + (h)) * HTB)
#define PG8_SB(b, h) ((4 + (b) * 2 + (h)) * HTB)
#define PG8_STAGE(bufoff, gbase, voff) do { _Pragma("unroll") for (int _i = 0; _i < 2; ++_i) \
        __builtin_amdgcn_global_load_lds((const unsigned*)((const char*)(gbase) + (voff)[_i]), (PG8_LAS unsigned*)(lds + (bufoff) + ldsw + _i * 8192), 16, 0, 0); } while (0)
#define PG8_LDA(dst, b, h) do { _Pragma("unroll") for (int m = 0; m < 4; ++m) _Pragma("unroll") for (int k = 0; k < 2; ++k) dst[m][k] = *(const PG8_LAS bf16x8*)(lds + PG8_SA(b, h) + aoff + m * 2048 + k * 1024); } while (0)
#define PG8_LDB(dst, b, h) do { _Pragma("unroll") for (int n = 0; n < 2; ++n) _Pragma("unroll") for (int k = 0; k < 2; ++k) dst[n][k] = *(const PG8_LAS bf16x8*)(lds + PG8_SB(b, h) + boff + n * 2048 + k * 1024); } while (0)
#define PG8_MMA(ai, bj, At, Bt) do { __builtin_amdgcn_s_setprio(1); _Pragma("unroll") for (int m = 0; m < 4; ++m) _Pragma("unroll") for (int n = 0; n < 2; ++n) _Pragma("unroll") for (int k = 0; k < 2; ++k) \
        acc[ai][bj][m][n] = __builtin_amdgcn_mfma_f32_16x16x32_bf16(Bt[n][k], At[m][k], acc[ai][bj][m][n], 0, 0, 0); __builtin_amdgcn_s_setprio(0); } while (0)
#define PG8_WAIT_V(n) asm volatile("s_waitcnt vmcnt(" #n ")" ::: "memory")
#define PG8_WAIT_L(n) asm volatile("s_waitcnt lgkmcnt(" #n ")" ::: "memory")
#define PG8_BAR __builtin_amdgcn_s_barrier()
#define PG8_SCHED __builtin_amdgcn_sched_barrier(0)
    Unit cur, nxt; int ui = 0;
    if (!S.next(0, cur)) return;
    f32x4 acc[2][2][4][2];
#pragma unroll
    for (int a = 0; a < 2; ++a)
#pragma unroll
        for (int b = 0; b < 2; ++b)
#pragma unroll
            for (int m = 0; m < 4; ++m)
#pragma unroll
                for (int n = 0; n < 2; ++n) acc[a][b][m][n] = (f32x4){0.f, 0.f, 0.f, 0.f};
    bf16x8 At[4][2], B0[2][2], B1[2][2];
    const char* cA = (const char*)g.A + (size_t)cur.pm * tstep; const char* cB = (const char*)g.Bt + (size_t)cur.pn * tstep;
    S.a_ready(cur);
    PG8_STAGE(PG8_SB(0, 0), cB, voffB); PG8_STAGE(PG8_SA(0, 0), cA, voffA); PG8_STAGE(PG8_SB(0, 1), cB + hstep, voffB); PG8_STAGE(PG8_SA(0, 1), cA + hstep, voffA);
    if (wr == 1) PG8_BAR;
    PG8_WAIT_V(4); PG8_BAR;
    PG8_STAGE(PG8_SB(1, 0), cB + kstep, voffB); PG8_STAGE(PG8_SA(1, 0), cA + kstep, voffA); PG8_STAGE(PG8_SB(1, 1), cB + hstep + kstep, voffB);
    PG8_WAIT_V(6); PG8_BAR;
    for (;;) {
        const bool has_next = S.next(ui + 1, nxt);
        const char* nA = has_next ? (const char*)g.A + (size_t)nxt.pm * tstep : cA; const char* nB = has_next ? (const char*)g.Bt + (size_t)nxt.pn * tstep : cB;
        for (int t = 0; t < nt; t += 2) {
            const bool last = (t == nt - 2);
            const char* a1 = cA + (size_t)(t + 1) * kstep;
            const char* a2 = last ? nA : cA + (size_t)(t + 2) * kstep; const char* b2 = last ? nB : cB + (size_t)(t + 2) * kstep;
            const char* a3 = a2 + kstep; const char* b3 = b2 + kstep;
            if (last && has_next) S.a_ready(nxt);
            PG8_LDB(B0, 0, 0); PG8_SCHED; PG8_LDA(At, 0, 0); PG8_STAGE(PG8_SA(1, 1), a1 + hstep, voffA);
            PG8_WAIT_L(8); PG8_BAR; PG8_WAIT_L(0); PG8_MMA(0, 0, At, B0); PG8_BAR; PG8_SCHED;
            PG8_LDB(B1, 0, 1); PG8_STAGE(PG8_SB(0, 0), b2, voffB);
            PG8_BAR; PG8_WAIT_L(0); PG8_MMA(0, 1, At, B1); PG8_BAR;
            PG8_LDA(At, 0, 1); PG8_STAGE(PG8_SA(0, 0), a2, voffA);
            PG8_BAR; PG8_WAIT_L(0); PG8_MMA(1, 0, At, B0); PG8_BAR; PG8_SCHED;
            PG8_STAGE(PG8_SB(0, 1), b2 + hstep, voffB);
            PG8_WAIT_V(6); PG8_BAR; PG8_MMA(1, 1, At, B1); PG8_BAR;
            PG8_LDB(B0, 1, 0); PG8_SCHED; PG8_LDA(At, 1, 0); PG8_STAGE(PG8_SA(0, 1), a2 + hstep, voffA);
            PG8_WAIT_L(8); PG8_BAR; PG8_WAIT_L(0); PG8_MMA(0, 0, At, B0); PG8_BAR; PG8_SCHED;
            PG8_LDB(B1, 1, 1); PG8_STAGE(PG8_SB(1, 0), b3, voffB);
            PG8_BAR; PG8_WAIT_L(0); PG8_MMA(0, 1, At, B1); PG8_BAR;
            PG8_LDA(At, 1, 1); PG8_STAGE(PG8_SA(1, 0), a3, voffA);
            PG8_BAR; PG8_WAIT_L(0); PG8_MMA(1, 0, At, B0); PG8_BAR; PG8_SCHED;
            PG8_STAGE(PG8_SB(1, 1), b3 + hstep, voffB);
            PG8_WAIT_V(6); PG8_BAR; PG8_MMA(1, 1, At, B1); PG8_BAR;
        }
        E(acc, cur, wr, wc, fr, fq);
        if (!has_next) break;
#pragma unroll
        for (int a = 0; a < 2; ++a)
#pragma unroll
            for (int b = 0; b < 2; ++b)
#pragma unroll
                for (int m = 0; m < 4; ++m)
#pragma unroll
                    for (int n = 0; n < 2; ++n) acc[a][b][m][n] = (f32x4){0.f, 0.f, 0.f, 0.f};
        cur = nxt; cA = nA; cB = nB; ++ui;
    }
    PG8_WAIT_V(0);
    if (wr == 0) PG8_BAR;
    PG8_BAR;
#undef PG8_SA
#undef PG8_SB
#undef PG8_STAGE
#undef PG8_LDA
#undef PG8_LDB
#undef PG8_MMA
#undef PG8_WAIT_V
#undef PG8_WAIT_L
#undef PG8_BAR
#undef PG8_SCHED
}
}

using pg8::bf16_t; using pg8::bf16x8; using pg8::f32x4; using pg8::u32x4; using pg8::cvt_pk_bf16; using pg8::Unit;
typedef float f32x16 __attribute__((ext_vector_type(16)));
typedef unsigned u32x2 __attribute__((ext_vector_type(2)));
typedef float f32x2 __attribute__((ext_vector_type(2)));
#define LAS __attribute__((address_space(3)))

constexpr int DM = 1024, NBATCH = 32, SEQ = 2048, CTXL = 256;
constexpr int NGRP = 2, BG = NBATCH / NGRP;
constexpr int TG = BG * SEQ, CGR = BG * CTXL, RG = CGR + TG;
constexpr int NA = 5376, NBC = 5120;
constexpr int MODW = 6 * DM;
constexpr float ALPHA = 1.189207115002721f;
constexpr int LDS_BYTES = 163840;
constexpr int XCH_OFF = 131072;

constexpr size_t OFF_MOD = 0;
constexpr size_t OFF_WA = 1048576;
constexpr size_t OFF_WB = OFF_WA + (size_t)NA * DM * 2;
constexpr size_t OFF_WBRS = OFF_WB + (size_t)NBC * DM * 2;
constexpr size_t OFF_WBRL = OFF_WBRS + (size_t)1024 * 2048 * 2;
constexpr size_t OFF_WOUT = OFF_WBRL + (size_t)1024 * 1024 * 2;
constexpr size_t OFF_W1 = OFF_WOUT + (size_t)1024 * 1024 * 2;
constexpr size_t OFF_W2 = OFF_W1 + (size_t)4096 * 1024 * 2;
constexpr size_t OFF_WG = OFF_W2 + (size_t)4096 * 1024 * 2;
constexpr size_t OFF_H0 = 51380224;
constexpr size_t OFF_A = OFF_H0 + (size_t)RG * DM * 2;
constexpr size_t SZ_A = 402653184;
constexpr size_t OFF_B = OFF_A + SZ_A;
constexpr size_t OFF_RAW = OFF_A;
constexpr size_t OFF_Y1 = OFF_A, OFF_Y2 = OFF_A + 134217728, OFF_YLF = OFF_A + 268435456, OFF_YLB = OFF_A + 335544320;
constexpr size_t OFF_X1 = OFF_A, OFF_H1 = OFF_A + 134217728, OFF_BR1 = OFF_A + 268435456;
constexpr size_t OFF_XT = OFF_B;
constexpr size_t OFF_BM = OFF_XT + (size_t)RG * 2048 * 2;
constexpr size_t OFF_BT = OFF_BM + (size_t)RG * 1024 * 2;
constexpr size_t OFF_CM = OFF_BT + (size_t)RG * 1024 * 2;
constexpr size_t OFF_U = OFF_CM + (size_t)RG * 1024 * 2;
constexpr size_t OFF_DT = OFF_U + (size_t)RG * 1024 * 2;
constexpr size_t WS_END = OFF_DT + (size_t)RG * 64 * 4;
constexpr size_t OFF_GATES = OFF_B, OFF_TMP = OFF_B + 134217728, OFF_MERGED = OFF_B + 268435456, OFF_HID = OFF_B, OFF_BR2 = OFF_B + 268435456;
static_assert(OFF_WG + 1048576 <= OFF_H0, "weights overflow");
static_assert(WS_END <= 1073741824ull, "workspace too large");

struct Params {
    const float *x, *c, *ctx, *c_ctx, *w_mod, *b_mod, *w_in, *b_gate, *ssd_conv_w, *ssd_conv_b, *ssd_dt_bias, *ssd_a_log, *ssd_d, *ssd_norm_w,
        *lru_conv_w, *lru_conv_b, *lru_wa, *lru_ba, *lru_wi, *lru_bi, *lru_lambda, *w_br_ssd, *w_br_lru, *w_out, *ln1_g, *ln1_b, *w_mlp1, *b_mlp1,
        *w_mlp2, *b_mlp2, *ln2_g, *ln2_b;
    float* out; unsigned char* ws;
};

__device__ __forceinline__ float bf2f(unsigned short b) { return __uint_as_float(((unsigned)b) << 16); }
__device__ __forceinline__ float bflo(unsigned w) { return __uint_as_float(w << 16); }
__device__ __forceinline__ float bfhi(unsigned w) { return __uint_as_float(w & 0xffff0000u); }
__device__ __forceinline__ unsigned short f2bf(float f) { return (unsigned short)(cvt_pk_bf16(f, 0.f) & 0xffffu); }
__device__ __forceinline__ float log1p_small(float e) { return e < 0.03f ? e * (1.f - e * (0.5f - e * (0.33333334f - 0.25f * e))) : __logf(1.f + e); }
__device__ __forceinline__ float sigmoidf_(float x) { return __builtin_amdgcn_rcpf(1.f + __expf(-x)); }
__device__ __forceinline__ float siluf_(float x) { return x * sigmoidf_(x); }
__device__ __forceinline__ float lane_get(float v, int src_lane) { return __int_as_float(__builtin_amdgcn_ds_bpermute(src_lane << 2, __float_as_int(v))); }
__device__ __forceinline__ float wave_sum(float v, int lane) {
#pragma unroll
    for (int o = 1; o < 64; o <<= 1) v += lane_get(v, lane ^ o);
    return v;
}
#define LDS_FENCE() asm volatile("s_waitcnt lgkmcnt(0)" ::: "memory")
__device__ __forceinline__ f32x16 mfma32(bf16x8 a, bf16x8 b, f32x16 c) { return __builtin_amdgcn_mfma_f32_32x32x16_bf16(a, b, c, 0, 0, 0); }
__device__ __forceinline__ bf16x8 pack_acc(const f32x16& v, int s) {
    u32x4 w;
    if (s == 0) { w.x = cvt_pk_bf16(v[0], v[1]); w.y = cvt_pk_bf16(v[2], v[3]); w.z = cvt_pk_bf16(v[4], v[5]); w.w = cvt_pk_bf16(v[6], v[7]); }
    else { w.x = cvt_pk_bf16(v[8], v[9]); w.y = cvt_pk_bf16(v[10], v[11]); w.z = cvt_pk_bf16(v[12], v[13]); w.w = cvt_pk_bf16(v[14], v[15]); }
    return __builtin_bit_cast(bf16x8, w);
}
__device__ __forceinline__ bf16x8 ld8(const bf16_t* p) { return *(const bf16x8*)p; }
__device__ __forceinline__ bf16x8 ld44(const bf16_t* p) {
    u32x2 lo = *(const u32x2*)p, hi = *(const u32x2*)(p + 8); u32x4 w; w.x = lo.x; w.y = lo.y; w.z = hi.x; w.w = hi.y; return __builtin_bit_cast(bf16x8, w);
}

__device__ __forceinline__ void tr_item(const float* W, int ldw, int col0, const float* kscale, bf16_t* WT, int K, int row0, LAS float* scr, int item, int nblk, int lane) {
    const int kb = item / nblk, nb = item % nblk, k0 = 64 * kb, n0 = 32 * nb;
#pragma unroll 8
    for (int i = 0; i < 32; ++i) { const int kk = 2 * i + (lane >> 5); float v = W[(size_t)(k0 + kk) * ldw + col0 + n0 + (lane & 31)]; if (kscale) v *= kscale[k0 + kk]; scr[kk * 33 + (lane & 31)] = v; }
    LDS_FENCE();
    const int c = lane & 7;
#pragma unroll
    for (int j = 0; j < 4; ++j) { const int n = (lane >> 3) + 8 * j; const LAS float* s = scr + (8 * c) * 33 + n;
        u32x4 o; o.x = cvt_pk_bf16(s[0 * 33], s[1 * 33]); o.y = cvt_pk_bf16(s[2 * 33], s[3 * 33]); o.z = cvt_pk_bf16(s[4 * 33], s[5 * 33]); o.w = cvt_pk_bf16(s[6 * 33], s[7 * 33]);
        *(u32x4*)(WT + (size_t)(row0 + n0 + n) * K + k0 + 8 * c) = o; }
    LDS_FENCE();
}
__device__ __forceinline__ void tr_matrix(const float* W, int ldw, int col0, int K, int N, const float* kscale, bf16_t* WT, int row0, LAS float* scr, int& base, int gw, int NGW, int lane) {
    const int nblk = N / 32, nitems = (K / 64) * nblk;
    int first = (gw - (base % NGW) + NGW) % NGW;
    for (int it = first; it < nitems; it += NGW) tr_item(W, ldw, col0, kscale, WT, K, row0, scr, it, nblk, lane);
    base += nitems;
}

__device__ __forceinline__ void phase_p0(const Params& p, LAS unsigned char* lds, int wg, int G, int tid, int wid, int lane) {
    float* mod = (float*)(p.ws + OFF_MOD);
    if (wg < 96) {
        LAS float* s = (LAS float*)lds;
        for (int idx = tid; idx < 33 * 1024; idx += 512) { const int b = idx >> 10, k = idx & 1023; const float v = (b < 32) ? p.c[b * 1024 + k] : p.c_ctx[k]; s[idx] = siluf_(v); }
        __syncthreads();
        const int col = wg * 64 + lane;
        float acc[33];
#pragma unroll
        for (int b = 0; b < 33; ++b) acc[b] = 0.f;
        float nw[8];
#pragma unroll
        for (int i = 0; i < 8; ++i) nw[i] = p.w_mod[(size_t)(wid * 128 + i) * MODW + col];
        for (int k = wid * 128; k < wid * 128 + 128; k += 8) {
            float w[8];
#pragma unroll
            for (int i = 0; i < 8; ++i) w[i] = nw[i];
            if (k + 8 < wid * 128 + 128) {
#pragma unroll
                for (int i = 0; i < 8; ++i) nw[i] = p.w_mod[(size_t)(k + 8 + i) * MODW + col]; }
#pragma unroll
            for (int b = 0; b < 33; ++b) { const f32x4 sv = *(const LAS f32x4*)(s + b * 1024 + k), sw = *(const LAS f32x4*)(s + b * 1024 + k + 4);
                acc[b] += (sv.x * w[0] + sv.y * w[1] + sv.z * w[2] + sv.w * w[3]) + (sw.x * w[4] + sw.y * w[5] + sw.z * w[6] + sw.w * w[7]); }
        }
        __syncthreads();
        LAS float* part = (LAS float*)lds;
#pragma unroll
        for (int b = 0; b < 33; ++b) part[(wid * 33 + b) * 64 + lane] = acc[b];
        __syncthreads();
        for (int idx = tid; idx < 33 * 64; idx += 512) { const int b = idx >> 6, l = idx & 63; float sum = 0.f;
#pragma unroll
            for (int w = 0; w < 8; ++w) sum += part[(w * 33 + b) * 64 + l];
            mod[b * MODW + wg * 64 + l] = sum + p.b_mod[wg * 64 + l]; }
        __syncthreads();
        return;
    }
    LAS float* scr = (LAS float*)(lds + wid * 8448);
    const int gw = (wg - 96) * 8 + wid, NGW = (G - 96) * 8; int base = 0;
    bf16_t* WA = (bf16_t*)(p.ws + OFF_WA); bf16_t* WB = (bf16_t*)(p.ws + OFF_WB);
    tr_matrix(p.w_in, 10304, 0, 1024, 3072, nullptr, WA, 0, scr, base, gw, NGW, lane);
    tr_matrix(p.w_in, 10304, 4160, 1024, 1024, nullptr, WA, 3072, scr, base, gw, NGW, lane);
    tr_matrix(p.w_in, 10304, 3136, 1024, 1024, nullptr, WA, 4096, scr, base, gw, NGW, lane);
    tr_matrix(p.w_in, 10304, 3072, 1024, 64, nullptr, WA, 5120, scr, base, gw, NGW, lane);
    tr_matrix(p.w_in, 10304, 5184, 1024, 5120, nullptr, WB, 0, scr, base, gw, NGW, lane);
    tr_matrix(p.w_br_ssd, 1024, 0, 2048, 1024, p.ssd_norm_w, (bf16_t*)(p.ws + OFF_WBRS), 0, scr, base, gw, NGW, lane);
    tr_matrix(p.w_br_lru, 1024, 0, 1024, 1024, nullptr, (bf16_t*)(p.ws + OFF_WBRL), 0, scr, base, gw, NGW, lane);
    tr_matrix(p.w_out, 1024, 0, 1024, 1024, nullptr, (bf16_t*)(p.ws + OFF_WOUT), 0, scr, base, gw, NGW, lane);
    tr_matrix(p.w_mlp1, 4096, 0, 1024, 4096, nullptr, (bf16_t*)(p.ws + OFF_W1), 0, scr, base, gw, NGW, lane);
    tr_matrix(p.w_mlp2, 1024, 0, 4096, 1024, nullptr, (bf16_t*)(p.ws + OFF_W2), 0, scr, base, gw, NGW, lane);
    bf16_t* WGt = (bf16_t*)(p.ws + OFF_WG);
    for (int m = 0; m < 16; ++m) {
        tr_matrix(p.lru_wa + (size_t)m * 16384, 128, 0, 128, 128, nullptr, WGt + (size_t)(m * 2 + 0) * 16384, 0, scr, base, gw, NGW, lane);
        tr_matrix(p.lru_wi + (size_t)m * 16384, 128, 0, 128, 128, nullptr, WGt + (size_t)(m * 2 + 1) * 16384, 0, scr, base, gw, NGW, lane);
    }
    for (int i = (wg - 96) * 512 + tid; i < 192 * 1024 / 8; i += (G - 96) * 512) *(u32x4*)(WA + (size_t)5184 * 1024 + (size_t)i * 8) = (u32x4){0u, 0u, 0u, 0u};
}

__device__ __forceinline__ const float* ln0_src(const Params& p, int g, int row) {
    return (row < CGR) ? p.ctx + ((size_t)g * CGR + row) * DM : p.x + ((size_t)g * TG + (row - CGR)) * DM;
}
__device__ __forceinline__ void phase_ln0(const Params& p, int g, int gw, int NGW, int lane) {
    const float* mod = (const float*)(p.ws + OFF_MOD); bf16_t* h0 = (bf16_t*)(p.ws + OFF_H0);
    f32x4 nx[4];
    if (gw < RG) { const float* src = ln0_src(p, g, gw);
#pragma unroll
        for (int j = 0; j < 4; ++j) nx[j] = *(const f32x4*)(src + 4 * lane + 256 * j); }
    for (int row = gw; row < RG; row += NGW) {
        const int mrow = (row < CGR) ? 32 : g * BG + (row - CGR) / SEQ;
        const float* sh = mod + (size_t)mrow * MODW; const float* sc = sh + DM;
        f32x4 v[4]; float s = 0.f;
#pragma unroll
        for (int j = 0; j < 4; ++j) { v[j] = nx[j]; s += (v[j].x + v[j].y) + (v[j].z + v[j].w); }
        if (row + NGW < RG) { const float* src = ln0_src(p, g, row + NGW);
#pragma unroll
            for (int j = 0; j < 4; ++j) nx[j] = *(const f32x4*)(src + 4 * lane + 256 * j); }
        const float mean = wave_sum(s, lane) * (1.f / DM); float s2 = 0.f;
#pragma unroll
        for (int j = 0; j < 4; ++j) { v[j] = v[j] - mean; s2 += (v[j].x * v[j].x + v[j].y * v[j].y) + (v[j].z * v[j].z + v[j].w * v[j].w); }
        const float rstd = __builtin_amdgcn_rsqf(wave_sum(s2, lane) * (1.f / DM) + 1e-6f);
#pragma unroll
        for (int j = 0; j < 4; ++j) { const int col = 4 * lane + 256 * j; const f32x4 a = *(const f32x4*)(sc + col), b = *(const f32x4*)(sh + col);
            const f32x4 o = v[j] * rstd * (a + 1.f) + b; u32x2 w; w.x = cvt_pk_bf16(o.x, o.y); w.y = cvt_pk_bf16(o.z, o.w);
            *(u32x2*)(h0 + (size_t)row * DM + col) = w; }
    }
}
__device__ __forceinline__ void phase_ln1(const Params& p, int g, int gw, int NGW, int lane) {
    const float* mod = (const float*)(p.ws + OFF_MOD); float* x1 = (float*)(p.ws + OFF_X1); bf16_t* h1 = (bf16_t*)(p.ws + OFF_H1);
    const float* xbase = p.x + (size_t)g * TG * DM; const bf16_t* brbase = (const bf16_t*)(p.ws + OFF_BR1);
    f32x4 gaH[4], beH[4];
#pragma unroll
    for (int j = 0; j < 4; ++j) { gaH[j] = *(const f32x4*)(p.ln1_g + 4 * lane + 256 * j); beH[j] = *(const f32x4*)(p.ln1_b + 4 * lane + 256 * j); }
    f32x4 nx[4]; u32x2 nb[4];
    if (gw < TG) {
#pragma unroll
        for (int j = 0; j < 4; ++j) { nx[j] = *(const f32x4*)(xbase + (size_t)gw * DM + 4 * lane + 256 * j); nb[j] = *(const u32x2*)(brbase + (size_t)gw * DM + 4 * lane + 256 * j); } }
    for (int row = gw; row < TG; row += NGW) {
        const int b = g * BG + row / SEQ; const float* sh = mod + (size_t)b * MODW + 3 * DM; const float* sc = sh + DM;
        float* xr = x1 + (size_t)row * DM;
        f32x4 v[4]; float s = 0.f;
#pragma unroll
        for (int j = 0; j < 4; ++j) { const u32x2 bw = nb[j];
            v[j] = nx[j] * ALPHA + (f32x4){bflo(bw.x), bfhi(bw.x), bflo(bw.y), bfhi(bw.y)}; s += (v[j].x + v[j].y) + (v[j].z + v[j].w); }
        if (row + NGW < TG) { const size_t nr = (size_t)(row + NGW) * DM;
#pragma unroll
            for (int j = 0; j < 4; ++j) { nx[j] = *(const f32x4*)(xbase + nr + 4 * lane + 256 * j); nb[j] = *(const u32x2*)(brbase + nr + 4 * lane + 256 * j); } }
        float mean = wave_sum(s, lane) * (1.f / DM); float s2 = 0.f;
#pragma unroll
        for (int j = 0; j < 4; ++j) { v[j] = v[j] - mean; s2 += (v[j].x * v[j].x + v[j].y * v[j].y) + (v[j].z * v[j].z + v[j].w * v[j].w); }
        float rstd = __builtin_amdgcn_rsqf(wave_sum(s2, lane) * (1.f / DM) + 1e-6f);
        s = 0.f;
#pragma unroll
        for (int j = 0; j < 4; ++j) { const int col = 4 * lane + 256 * j; const f32x4 ga = gaH[j], be = beH[j];
            v[j] = v[j] * rstd * ga + be; *(f32x4*)(xr + col) = v[j]; s += (v[j].x + v[j].y) + (v[j].z + v[j].w); }
        mean = wave_sum(s, lane) * (1.f / DM); s2 = 0.f;
#pragma unroll
        for (int j = 0; j < 4; ++j) { v[j] = v[j] - mean; s2 += (v[j].x * v[j].x + v[j].y * v[j].y) + (v[j].z * v[j].z + v[j].w * v[j].w); }
        rstd = __builtin_amdgcn_rsqf(wave_sum(s2, lane) * (1.f / DM) + 1e-6f);
#pragma unroll
        for (int j = 0; j < 4; ++j) { const int col = 4 * lane + 256 * j; const f32x4 a = *(const f32x4*)(sc + col), bb = *(const f32x4*)(sh + col);
            const f32x4 o = v[j] * rstd * (a + 1.f) + bb; u32x2 w; w.x = cvt_pk_bf16(o.x, o.y); w.y = cvt_pk_bf16(o.z, o.w);
            *(u32x2*)(h1 + (size_t)row * DM + col) = w; }
    }
}
__device__ __forceinline__ void phase_ln2(const Params& p, int g, int gw, int NGW, int lane) {
    const float* x1base = (const float*)(p.ws + OFF_X1); const bf16_t* brbase = (const bf16_t*)(p.ws + OFF_BR2);
    f32x4 gaH[4], beH[4];
#pragma unroll
    for (int j = 0; j < 4; ++j) { gaH[j] = *(const f32x4*)(p.ln2_g + 4 * lane + 256 * j); beH[j] = *(const f32x4*)(p.ln2_b + 4 * lane + 256 * j); }
    f32x4 nx[4]; u32x2 nb[4];
    if (gw < TG) {
#pragma unroll
        for (int j = 0; j < 4; ++j) { nx[j] = *(const f32x4*)(x1base + (size_t)gw * DM + 4 * lane + 256 * j); nb[j] = *(const u32x2*)(brbase + (size_t)gw * DM + 4 * lane + 256 * j); } }
    for (int row = gw; row < TG; row += NGW) {
        float* xr = p.out + ((size_t)g * TG + row) * DM;
        f32x4 v[4]; float s = 0.f;
#pragma unroll
        for (int j = 0; j < 4; ++j) { const u32x2 bw = nb[j];
            v[j] = nx[j] * ALPHA + (f32x4){bflo(bw.x), bfhi(bw.x), bflo(bw.y), bfhi(bw.y)}; s += (v[j].x + v[j].y) + (v[j].z + v[j].w); }
        if (row + NGW < TG) { const size_t nr = (size_t)(row + NGW) * DM;
#pragma unroll
            for (int j = 0; j < 4; ++j) { nx[j] = *(const f32x4*)(x1base + nr + 4 * lane + 256 * j); nb[j] = *(const u32x2*)(brbase + nr + 4 * lane + 256 * j); } }
        const float mean = wave_sum(s, lane) * (1.f / DM); float s2 = 0.f;
#pragma unroll
        for (int j = 0; j < 4; ++j) { v[j] = v[j] - mean; s2 += (v[j].x * v[j].x + v[j].y * v[j].y) + (v[j].z * v[j].z + v[j].w * v[j].w); }
        const float rstd = __builtin_amdgcn_rsqf(wave_sum(s2, lane) * (1.f / DM) + 1e-6f);
#pragma unroll
        for (int j = 0; j < 4; ++j) { const int col = 4 * lane + 256 * j;
            *(f32x4*)(xr + col) = v[j] * rstd * gaH[j] + beH[j]; }
    }
}

__device__ __forceinline__ void conv_fetch(const bf16_t* raw, int item, int tid, u32x4 (&rg)[3]) {
    constexpr int NFB = 80;
    const int ch = item / NFB, fb = item % NFB;
    const bool is_ctx = ch < (CGR / 128);
    const long row0 = (long)ch * 128;
#pragma unroll
    for (int i = 0; i < 3; ++i) {
        const int idx = tid + 512 * i;
        rg[i] = (u32x4){0u, 0u, 0u, 0u};
        if (idx < 134 * 8) { const int ir = idx >> 3, c8 = idx & 7; int tok; bool ok;
            if (is_ctx) { tok = ir - 2; const int gt = (ch & 1) * 128 + tok; ok = (ir < 131) && gt >= 0 && gt < 256; }
            else { const int sg = ir >= 67 ? 1 : 0, q = ir - 67 * sg; tok = 64 * sg + q - 2; ok = q >= 2 && q < 66; }
            if (ok) rg[i] = *(const u32x4*)(raw + (size_t)(row0 + tok) * NA + fb * 64 + c8 * 8); }
    }
}
__device__ __forceinline__ void phase_conv(const Params& p, LAS unsigned char* lds, int wg, int G, int tid) {
    const bf16_t* raw = (const bf16_t*)(p.ws + OFF_RAW);
    bf16_t* xT = (bf16_t*)(p.ws + OFF_XT); bf16_t* bm = (bf16_t*)(p.ws + OFF_BM); bf16_t* bT = (bf16_t*)(p.ws + OFF_BT);
    bf16_t* cm = (bf16_t*)(p.ws + OFF_CM); bf16_t* uu = (bf16_t*)(p.ws + OFF_U); float* dt = (float*)(p.ws + OFF_DT);
    constexpr int NCH = RG / 128, NFB = 80, NIT = NCH * NFB;
    const int f = tid & 63, tg = tid >> 6;
    for (int ch = wg; ch < NCH; ch += G) {
        const float bias = p.ssd_dt_bias[f];
        unsigned short rv[16];
#pragma unroll
        for (int k = 0; k < 16; ++k) rv[k] = raw[((size_t)ch * 128 + tg * 16 + k) * NA + 5120 + f];
#pragma unroll
        for (int k = 0; k < 16; ++k) { const size_t row = (size_t)ch * 128 + tg * 16 + k; const float v = bf2f(rv[k]) + bias;
            dt[row * 64 + f] = v > 20.f ? v : log1p_small(__expf(v)); }
    }
    u32x4 rg[3];
    int item = wg, buf = 0;
    if (item < NIT) conv_fetch(raw, item, tid, rg);
    for (; item < NIT; item += G) {
        LAS float* tile = (LAS float*)(lds + buf * 34816);
#pragma unroll
        for (int i = 0; i < 3; ++i) { const int idx = tid + 512 * i;
            if (idx < 134 * 8) { LAS float* d = tile + (idx >> 3) * 64 + (idx & 7) * 8; const u32x4 w = rg[i];
                *(LAS f32x4*)d = (f32x4){bflo(w.x), bfhi(w.x), bflo(w.y), bfhi(w.y)}; *(LAS f32x4*)(d + 4) = (f32x4){bflo(w.z), bfhi(w.z), bflo(w.w), bfhi(w.w)}; } }
        __syncthreads();
        if (item + G < NIT) conv_fetch(raw, item + G, tid, rg);
        const int ch = item / NFB, fb = item % NFB;
        const size_t row0 = (size_t)ch * 128;
        const int fp = tid & 31, tq = tid >> 5;
        const int feat = fb * 64 + 2 * fp;
        f32x2 w0, w1, w2, w3, bias;
        if (feat < 4096) { w0 = *(const f32x2*)(p.ssd_conv_w + feat); w1 = *(const f32x2*)(p.ssd_conv_w + 4096 + feat); w2 = *(const f32x2*)(p.ssd_conv_w + 8192 + feat); w3 = *(const f32x2*)(p.ssd_conv_w + 12288 + feat); bias = *(const f32x2*)(p.ssd_conv_b + feat); }
        else { const int lf = feat - 4096; w0 = *(const f32x2*)(p.lru_conv_w + lf); w1 = *(const f32x2*)(p.lru_conv_w + 1024 + lf); w2 = *(const f32x2*)(p.lru_conv_w + 2048 + lf); w3 = *(const f32x2*)(p.lru_conv_w + 3072 + lf); bias = *(const f32x2*)(p.lru_conv_b + lf); }
        const bool is_ctx = ch < (CGR / 128);
        const bool act = fb < 64;
        f32x2 o[8];
        const int ib0 = is_ctx ? tq * 8 : (tq >> 3) * 67 + (tq & 7) * 8;
        const LAS f32x2* tp = (const LAS f32x2*)tile + fp;
        f32x2 v0 = tp[(ib0 + 0) * 32], v1 = tp[(ib0 + 1) * 32], v2 = tp[(ib0 + 2) * 32];
#pragma unroll
        for (int k = 0; k < 8; ++k) {
            const f32x2 v3 = tp[(ib0 + k + 3) * 32];
            f32x2 a = bias + w0 * v0 + w1 * v1 + w2 * v2 + w3 * v3;
            if (act) { f32x2 d; d.x = 1.f + __expf(-a.x); d.y = 1.f + __expf(-a.y); f32x2 rc; rc.x = __builtin_amdgcn_rcpf(d.x); rc.y = __builtin_amdgcn_rcpf(d.y); a = a * rc; }
            o[k] = a;
            v0 = v1; v1 = v2; v2 = v3;
        }
        if (fb < 48) {
            bf16_t* dst = (fb < 32) ? xT + ((size_t)ch * 2048 + feat) * 128 + tq * 8 : bT + ((size_t)ch * 1024 + (feat - 2048)) * 128 + tq * 8;
            u32x4 a, b; a.x = cvt_pk_bf16(o[0].x, o[1].x); a.y = cvt_pk_bf16(o[2].x, o[3].x); a.z = cvt_pk_bf16(o[4].x, o[5].x); a.w = cvt_pk_bf16(o[6].x, o[7].x);
            b.x = cvt_pk_bf16(o[0].y, o[1].y); b.y = cvt_pk_bf16(o[2].y, o[3].y); b.z = cvt_pk_bf16(o[4].y, o[5].y); b.w = cvt_pk_bf16(o[6].y, o[7].y);
            *(u32x4*)dst = a; *(u32x4*)(dst + 128) = b;
        }
        if (fb >= 32 && !(is_ctx && fb >= 48 && fb < 64)) {
            bf16_t* dst = (fb < 48) ? bm + (feat - 2048) : (fb < 64) ? cm + (feat - 3072) : uu + (feat - 4096);
#pragma unroll
            for (int k = 0; k < 8; ++k) *(unsigned*)(dst + (row0 + tq * 8 + k) * 1024) = cvt_pk_bf16(o[k].x, o[k].y);
        }
        buf ^= 1;
    }
    __syncthreads();
}

__device__ __forceinline__ float wave_prefix(float v, int lane) {
#pragma unroll
    for (int o = 1; o < 64; o <<= 1) { const float t = lane_get(v, (lane - o) & 63); if (lane >= o) v += t; }
    return v;
}
__device__ __forceinline__ float wave_suffix(float v, int lane) {
#pragma unroll
    for (int o = 1; o < 64; o <<= 1) { const float t = lane_get(v, (lane + o) & 63); if (lane + o < 64) v += t; }
    return v;
}
__device__ __forceinline__ void tile_load(LAS unsigned char* dst, const bf16_t* g, int gstride, int wid, int lane) {
#pragma unroll
    for (int i = 0; i < 4; ++i) {
        const int instr = wid * 4 + i, row = 4 * instr + (lane >> 4), lc = (lane & 15) ^ (row & 15);
        __builtin_amdgcn_global_load_lds((const unsigned*)(g + (size_t)row * gstride + lc * 8), (LAS unsigned*)(dst + instr * 1024), 16, 0, 0);
    }
}
__device__ __forceinline__ bf16x8 t_ld8(const LAS unsigned char* t, unsigned rowoff, unsigned rx4, int col16) { return *(const LAS bf16x8*)(t + rowoff + (((unsigned)col16 << 4) ^ rx4)); }
__device__ __forceinline__ bf16x8 t_ld44(const LAS unsigned char* t, unsigned rowoff, unsigned rx4, int col16, int h) {
    const u32x2 lo = *(const LAS u32x2*)(t + rowoff + (((unsigned)col16 << 4) ^ rx4) + 8 * h), hi = *(const LAS u32x2*)(t + rowoff + (((unsigned)(col16 + 1) << 4) ^ rx4) + 8 * h);
    u32x4 w; w.x = lo.x; w.y = lo.y; w.z = hi.x; w.w = hi.y; return __builtin_bit_cast(bf16x8, w);
}
template <int DIR, int MODE = 0>
__device__ __forceinline__ void ssd_item(const Params& p, int item, LAS unsigned char* lds, int wid, int lane) {
    const int bl = item >> 3, grp = item & 7;
    const int head = grp * 4 + (wid >> 1), pb = wid & 1;
    const int r = lane & 31, h = lane >> 5;
    const unsigned rowoff = (unsigned)r * 256u, rx4 = (unsigned)(r & 15) << 4;
    LAS unsigned char* TA = lds; LAS unsigned char* TB = lds + 32768; LAS unsigned char* TC = lds + 65536;
    LAS unsigned char* CBL = lds + 131072;
    LAS float* cumL = (LAS float*)(lds + 98304 + wid * 4096); LAS float* dtL = cumL + 128; LAS float* sclL = cumL + 256; LAS float* wL = cumL + 384;
    const bf16_t* xT = (const bf16_t*)(p.ws + OFF_XT); const bf16_t* bm = (const bf16_t*)(p.ws + OFF_BM); const bf16_t* bT = (const bf16_t*)(p.ws + OFF_BT);
    const bf16_t* cm = (const bf16_t*)(p.ws + OFF_CM); const float* dt = (const float*)(p.ws + OFF_DT);
    bf16_t* yout = (bf16_t*)(p.ws + (DIR ? OFF_Y2 : OFF_Y1));
    const float a_neg = -__expf(p.ssd_a_log[DIR * 32 + head]);
    const float Dh = p.ssd_d[head];
    f32x16 H[4];
#pragma unroll
    for (int nb = 0; nb < 4; ++nb)
#pragma unroll
        for (int e = 0; e < 16; ++e) H[nb][e] = 0.f;
    asm volatile("" ::: "memory"); __builtin_amdgcn_s_barrier(); asm volatile("" ::: "memory");
    { const int ch0 = bl * 2 + (DIR ? 1 : 0); tile_load(TC, bT + ((size_t)ch0 * 1024 + grp * 128) * 128, 128, wid, lane); }
    float nd0, nd1;
    { const size_t r0 = (size_t)(bl * 2 + (DIR ? 1 : 0)) * 128; nd0 = dt[(r0 + lane) * 64 + DIR * 32 + head]; nd1 = dt[(r0 + 64 + lane) * 64 + DIR * 32 + head]; }
#pragma unroll 1
    for (int s = 0; s < 18; ++s) {
        const bool is_ctx = s < 2;
        const int c = is_ctx ? (DIR ? 1 - s : s) : (DIR ? 17 - s : s - 2);
        const int chunk = is_ctx ? bl * 2 + c : (CGR / 128) + bl * 16 + c;
        const size_t row0 = (size_t)chunk * 128;
        const float d0 = nd0, d1 = nd1;
        const bf16_t* XT = xT + ((size_t)chunk * 2048 + head * 64 + pb * 32 + r) * 128;
        asm volatile("s_waitcnt vmcnt(0)" ::: "memory"); __builtin_amdgcn_s_barrier(); asm volatile("" ::: "memory");
        if (s + 1 < 18) { const int s1 = s + 1; const bool cx1 = s1 < 2; const int c1 = cx1 ? (DIR ? 1 - s1 : s1) : (DIR ? 17 - s1 : s1 - 2);
            const size_t rn = (size_t)(cx1 ? bl * 2 + c1 : (CGR / 128) + bl * 16 + c1) * 128;
            nd0 = dt[(rn + lane) * 64 + DIR * 32 + head]; nd1 = dt[(rn + 64 + lane) * 64 + DIR * 32 + head]; }
        float c0, c1, ctot;
        if (DIR == 0) { const float p0 = wave_prefix(d0 * a_neg, lane); const float tot0 = __int_as_float(__builtin_amdgcn_readlane(__float_as_int(p0), 63)); const float p1 = wave_prefix(d1 * a_neg, lane) + tot0; c0 = p0; c1 = p1; ctot = __int_as_float(__builtin_amdgcn_readlane(__float_as_int(p1), 63)); }
        else { const float s1 = wave_suffix(d1 * a_neg, lane); const float tot1 = __int_as_float(__builtin_amdgcn_readlane(__float_as_int(s1), 0)); const float s0 = wave_suffix(d0 * a_neg, lane) + tot1; c0 = s0; c1 = s1; ctot = __int_as_float(__builtin_amdgcn_readlane(__float_as_int(s0), 0)); }
        cumL[lane] = c0; cumL[lane + 64] = c1; dtL[lane] = d0; dtL[lane + 64] = d1;
        sclL[lane] = d0 * __expf(ctot - c0); sclL[lane + 64] = d1 * __expf(ctot - c1);
        LDS_FENCE();
        float mref[4];
        if (DIR == 0) { mref[0] = 0.f; mref[1] = cumL[31]; mref[2] = cumL[63]; mref[3] = cumL[95]; }
        else { mref[0] = cumL[32]; mref[1] = cumL[64]; mref[2] = cumL[96]; mref[3] = 0.f; }
#pragma unroll
        for (int ib = 0; ib < 4; ++ib) mref[ib] = __int_as_float(__builtin_amdgcn_readfirstlane(__float_as_int(mref[ib])));
        if (!is_ctx) {
#pragma unroll
            for (int ib = 0; ib < 4; ++ib) { wL[ib * 128 + lane] = d0 * __expf(mref[ib] - c0); wL[ib * 128 + 64 + lane] = d1 * __expf(mref[ib] - c1); }
            LDS_FENCE();
#pragma unroll 1
            for (int bidx = wid; bidx < 10; bidx += 8) {
                int bi2 = bidx >= 6 ? 3 : bidx >= 3 ? 2 : bidx >= 1 ? 1 : 0; int bj2 = bidx - bi2 * (bi2 + 1) / 2;
                const int ibk = DIR ? 3 - bi2 : bi2, jbk = DIR ? 3 - bj2 : bj2;
                const unsigned io2 = rowoff + (unsigned)ibk * 8192u, jo2 = rowoff + (unsigned)jbk * 8192u;
                f32x16 S;
#pragma unroll
                for (int e = 0; e < 16; ++e) S[e] = 0.f;
#pragma unroll
                for (int s8 = 0; s8 < 8; ++s8) S = mfma32(t_ld8(TB, jo2, rx4, 2 * s8 + h), t_ld8(TA, io2, rx4, 2 * s8 + h), S);
                asm volatile("s_nop 15\n\ts_nop 3" : "+v"(S));
                LAS u32x4* dstp = (LAS u32x4*)(CBL + bidx * 2048 + lane * 16);
                u32x4 w0, w1; w0.x = cvt_pk_bf16(S[0], S[1]); w0.y = cvt_pk_bf16(S[2], S[3]); w0.z = cvt_pk_bf16(S[4], S[5]); w0.w = cvt_pk_bf16(S[6], S[7]);
                w1.x = cvt_pk_bf16(S[8], S[9]); w1.y = cvt_pk_bf16(S[10], S[11]); w1.z = cvt_pk_bf16(S[12], S[13]); w1.w = cvt_pk_bf16(S[14], S[15]);
                dstp[0] = w0; dstp[64] = w1;
            }
            LDS_FENCE();
            asm volatile("" ::: "memory"); __builtin_amdgcn_s_barrier(); asm volatile("" ::: "memory");
        }
        if (!is_ctx && MODE != 1) {
            bf16_t* Y = yout + ((size_t)(bl * 16 + c) * 128) * 2048 + head * 64 + pb * 32;
#pragma unroll 1
            for (int ib = 0; ib < 4; ++ib) {
                const unsigned ioff = rowoff + (unsigned)ib * 8192u;
                f32x16 Ya;
#pragma unroll
                for (int e = 0; e < 16; ++e) Ya[e] = 0.f;
#pragma unroll
                for (int nb = 0; nb < 4; ++nb)
#pragma unroll
                    for (int sp = 0; sp < 2; ++sp) Ya = mfma32(pack_acc(H[nb], sp), t_ld44(TA, ioff, rx4, 4 * nb + 2 * sp, h), Ya);
                const float ci = cumL[32 * ib + r];
                const float mi = (ib == 0) ? mref[0] : (ib == 1) ? mref[1] : (ib == 2) ? mref[2] : mref[3];
                { const float em = __expf(mi);
#pragma unroll
                  for (int e = 0; e < 16; ++e) Ya[e] *= em; }
#pragma unroll 3
                for (int jb = (DIR ? ib + 1 : 0); jb < (DIR ? 4 : ib); ++jb) {
                    f32x16 S;
                    { const int bi2 = DIR ? 3 - ib : ib, bj2 = DIR ? 3 - jb : jb; const LAS u32x4* srcp = (const LAS u32x4*)(CBL + (bi2 * (bi2 + 1) / 2 + bj2) * 2048 + lane * 16);
                      const u32x4 w0 = srcp[0], w1 = srcp[64];
                      S[0] = bflo(w0.x); S[1] = bfhi(w0.x); S[2] = bflo(w0.y); S[3] = bfhi(w0.y); S[4] = bflo(w0.z); S[5] = bfhi(w0.z); S[6] = bflo(w0.w); S[7] = bfhi(w0.w);
                      S[8] = bflo(w1.x); S[9] = bfhi(w1.x); S[10] = bflo(w1.y); S[11] = bfhi(w1.y); S[12] = bflo(w1.z); S[13] = bfhi(w1.z); S[14] = bflo(w1.w); S[15] = bfhi(w1.w); }
#pragma unroll
                    for (int q = 0; q < 4; ++q) { const f32x4 w4 = *(const LAS f32x4*)(wL + ib * 128 + 32 * jb + 8 * q + 4 * h);
#pragma unroll
                        for (int k = 0; k < 4; ++k) S[4 * q + k] *= w4[k]; }
                    Ya = mfma32(ld44(XT + 32 * jb + 4 * h), pack_acc(S, 0), Ya); Ya = mfma32(ld44(XT + 32 * jb + 16 + 4 * h), pack_acc(S, 1), Ya);
                }
                { const float ec = __expf(ci - mi);
#pragma unroll
                  for (int e = 0; e < 16; ++e) Ya[e] *= ec; }
                {
                    const int i = 32 * ib + r; const int jb = ib;
                    f32x16 S;
                    { const int bi2 = DIR ? 3 - ib : ib, bj2 = DIR ? 3 - jb : jb; const LAS u32x4* srcp = (const LAS u32x4*)(CBL + (bi2 * (bi2 + 1) / 2 + bj2) * 2048 + lane * 16);
                      const u32x4 w0 = srcp[0], w1 = srcp[64];
                      S[0] = bflo(w0.x); S[1] = bfhi(w0.x); S[2] = bflo(w0.y); S[3] = bfhi(w0.y); S[4] = bflo(w0.z); S[5] = bfhi(w0.z); S[6] = bflo(w0.w); S[7] = bfhi(w0.w);
                      S[8] = bflo(w1.x); S[9] = bfhi(w1.x); S[10] = bflo(w1.y); S[11] = bfhi(w1.y); S[12] = bflo(w1.z); S[13] = bfhi(w1.z); S[14] = bflo(w1.w); S[15] = bfhi(w1.w); }
#pragma unroll
                    for (int q = 0; q < 4; ++q) {
                        const int j0 = 32 * jb + 8 * q + 4 * h;
                        const f32x4 cj = *(const LAS f32x4*)(cumL + j0), dj = *(const LAS f32x4*)(dtL + j0);
#pragma unroll
                        for (int k = 0; k < 4; ++k) {
                            const int j = j0 + k; const bool valid = DIR ? (j >= i) : (j <= i);
                            float v = S[4 * q + k] * __expf(ci - cj[k]) * dj[k];
                            v = valid ? v : 0.f;
                            if (DIR == 0 && j == i) v += Dh;
                            S[4 * q + k] = v;
                        }
                    }
                    Ya = mfma32(ld44(XT + 32 * jb + 4 * h), pack_acc(S, 0), Ya); Ya = mfma32(ld44(XT + 32 * jb + 16 + 4 * h), pack_acc(S, 1), Ya);
                }
                asm volatile("s_nop 15\n\ts_nop 3" : "+v"(Ya));
                bf16_t* yr = Y + (size_t)(32 * ib + r) * 2048 + 4 * h;
#pragma unroll
                for (int q = 0; q < 4; ++q) { u32x2 w; w.x = cvt_pk_bf16(Ya[4 * q], Ya[4 * q + 1]); w.y = cvt_pk_bf16(Ya[4 * q + 2], Ya[4 * q + 3]); if (MODE != 3 || w.x == 0x12345678u) *(u32x2*)(yr + 8 * q) = w; }
            }
        }
        const float dec = __expf(ctot);
#pragma unroll
        for (int nb = 0; nb < 4; ++nb)
#pragma unroll
            for (int e = 0; e < 16; ++e) H[nb][e] *= dec;
#pragma unroll
        for (int s8 = 0; s8 < ((MODE == 2 || MODE == 3) ? 0 : 8); ++s8) {
            const u32x4 xr = *(const u32x4*)(XT + 16 * s8 + 8 * h);
            const f32x4 sa = *(const LAS f32x4*)(sclL + 16 * s8 + 8 * h), sb = *(const LAS f32x4*)(sclL + 16 * s8 + 8 * h + 4);
            u32x4 w; w.x = cvt_pk_bf16(bflo(xr.x) * sa.x, bfhi(xr.x) * sa.y); w.y = cvt_pk_bf16(bflo(xr.y) * sa.z, bfhi(xr.y) * sa.w);
            w.z = cvt_pk_bf16(bflo(xr.z) * sb.x, bfhi(xr.z) * sb.y); w.w = cvt_pk_bf16(bflo(xr.w) * sb.z, bfhi(xr.w) * sb.w);
            const bf16x8 Xs = __builtin_bit_cast(bf16x8, w);
#pragma unroll
            for (int nb = 0; nb < 4; ++nb) H[nb] = mfma32(t_ld8(TC, rowoff + (unsigned)nb * 8192u, rx4, 2 * s8 + h), Xs, H[nb]);
        }
        asm volatile("" ::: "memory"); __builtin_amdgcn_s_barrier(); asm volatile("" ::: "memory");
        if (s + 1 < 18) {
            const int s1 = s + 1; const bool ctx1 = s1 < 2; const int c1n = ctx1 ? (DIR ? 1 - s1 : s1) : (DIR ? 17 - s1 : s1 - 2);
            const int chn = ctx1 ? bl * 2 + c1n : (CGR / 128) + bl * 16 + c1n;
            tile_load(TC, bT + ((size_t)chn * 1024 + grp * 128) * 128, 128, wid, lane);
            if (!ctx1) { const size_t rown = (size_t)chn * 128; tile_load(TA, cm + rown * 1024 + grp * 128, 1024, wid, lane); tile_load(TB, bm + rown * 1024 + grp * 128, 1024, wid, lane); }
        }
    }
    asm volatile("s_waitcnt vmcnt(0)" ::: "memory");
}

template <int DIR>
__device__ __forceinline__ void lru_item(const Params& p, int item, int lane) {
    const int db = item & 3, blk = (item >> 2) & 7, bl = item >> 5;
    const int r = lane & 31, h = lane >> 5;
    const int dl = db * 32 + r, d = blk * 128 + dl;
    const bf16_t* WGt = (const bf16_t*)(p.ws + OFF_WG);
    const bf16_t* wa = WGt + ((size_t)((DIR * 8 + blk) * 2 + 0) * 128 + dl) * 128 + 8 * h;
    const bf16_t* wi = WGt + ((size_t)((DIR * 8 + blk) * 2 + 1) * 128 + dl) * 128 + 8 * h;
    bf16x8 Wa[8], Wi[8];
#pragma unroll
    for (int s = 0; s < 8; ++s) { Wa[s] = ld8(wa + 16 * s); Wi[s] = ld8(wi + 16 * s); }
    bf16x8 I0, I1;
#pragma unroll
    for (int e = 0; e < 8; ++e) { I0[e] = (16 * (2 * db) + 8 * h + e == dl) ? (short)0x3F80 : (short)0; I1[e] = (16 * (2 * db + 1) + 8 * h + e == dl) ? (short)0x3F80 : (short)0; }
    const float ba = p.lru_ba[DIR * 1024 + d], bi = p.lru_bi[DIR * 1024 + d];
    const float c8 = -8.f * log1p_small(__expf(-p.lru_lambda[DIR * 1024 + d]));
    const bf16_t* uu = (const bf16_t*)(p.ws + OFF_U);
    bf16_t* yl = (bf16_t*)(p.ws + (DIR ? OFF_YLB : OFF_YLF));
    float hst = 0.f;
    auto tile_row0 = [&](int t) -> size_t { const bool cx = t < 8; const int tl = cx ? (DIR ? 7 - t : t) : (DIR ? 71 - t : t - 8);
        return cx ? (size_t)bl * 256 + tl * 32 : (size_t)CGR + (size_t)bl * 2048 + tl * 32; };
    bf16x8 uf[8], ui0, ui1;
    { const bf16_t* up = uu + (tile_row0(0) + r) * 1024 + blk * 128 + 8 * h;
#pragma unroll
      for (int s = 0; s < 8; ++s) uf[s] = ld8(up + 16 * s);
      ui0 = ld8(up + 32 * db); ui1 = ld8(up + 32 * db + 16); }
#pragma unroll 1
    for (int t = 0; t < 72; ++t) {
        const bool is_ctx = t < 8;
        const int tile = is_ctx ? (DIR ? 7 - t : t) : (DIR ? 71 - t : t - 8);
        f32x16 Aa, Ai, Au;
#pragma unroll
        for (int e = 0; e < 16; ++e) { Aa[e] = 0.f; Ai[e] = 0.f; Au[e] = 0.f; }
#pragma unroll
        for (int s = 0; s < 8; ++s) { Aa = mfma32(uf[s], Wa[s], Aa); Ai = mfma32(uf[s], Wi[s], Ai); }
        Au = mfma32(ui0, I0, Au); Au = mfma32(ui1, I1, Au);
        { const int tn = t + 1 < 72 ? t + 1 : 71; const bf16_t* up = uu + (tile_row0(tn) + r) * 1024 + blk * 128 + 8 * h;
#pragma unroll
          for (int s = 0; s < 8; ++s) uf[s] = ld8(up + 16 * s);
          ui0 = ld8(up + 32 * db); ui1 = ld8(up + 32 * db + 16); }
        float av[16], bv[16];
#pragma unroll
        for (int e = 0; e < 16; e += 2) {
            const f32x2 xa = (f32x2){Aa[e], Aa[e + 1]} + ba, xi = (f32x2){Ai[e], Ai[e + 1]} + bi, uv = (f32x2){Au[e], Au[e + 1]};
            const f32x2 ta = xa * -1.4426950408889634f, ti = xi * -1.4426950408889634f;
            f32x2 da, di; da.x = __builtin_amdgcn_exp2f(ta.x); da.y = __builtin_amdgcn_exp2f(ta.y); di.x = __builtin_amdgcn_exp2f(ti.x); di.y = __builtin_amdgcn_exp2f(ti.y);
            da = da + 1.f; di = di + 1.f;
            f32x2 ra, ri; ra.x = __builtin_amdgcn_rcpf(da.x); ra.y = __builtin_amdgcn_rcpf(da.y); ri.x = __builtin_amdgcn_rcpf(di.x); ri.y = __builtin_amdgcn_rcpf(di.y);
            const f32x2 la = ra * (c8 * 1.4426950408889634f);
            f32x2 a; a.x = __builtin_amdgcn_exp2f(la.x); a.y = __builtin_amdgcn_exp2f(la.y);
            f32x2 om = 1.f - a * a; om.x = fmaxf(om.x, 0.f); om.y = fmaxf(om.y, 0.f);
            f32x2 sq; sq.x = __builtin_amdgcn_sqrtf(om.x); sq.y = __builtin_amdgcn_sqrtf(om.y);
            const f32x2 b = sq * (ri * uv);
            const int k0 = DIR ? 15 - e : e, k1 = DIR ? 14 - e : e + 1;
            av[k0] = a.x; bv[k0] = b.x; av[k1] = a.y; bv[k1] = b.y;
        }
        const int hh = DIR ? 1 - h : h;
        float Ag[4], Bg[4];
#pragma unroll
        for (int q = 0; q < 4; q += 2) {
            f32x2 A = (f32x2){av[4 * q], av[4 * q + 4]}, B = (f32x2){bv[4 * q], bv[4 * q + 4]};
#pragma unroll
            for (int k = 1; k < 4; ++k) { const f32x2 ak = (f32x2){av[4 * q + k], av[4 * q + 4 + k]}, bk = (f32x2){bv[4 * q + k], bv[4 * q + 4 + k]};
                A = A * ak; B = B * ak + bk; av[4 * q + k] = A.x; av[4 * q + 4 + k] = A.y; bv[4 * q + k] = B.x; bv[4 * q + 4 + k] = B.y; }
            Ag[q] = A.x; Ag[q + 1] = A.y; Bg[q] = B.x; Bg[q + 1] = B.y;
        }
        float Ap[4], Bp[4];
#pragma unroll
        for (int q = 0; q < 4; ++q) { Ap[q] = lane_get(Ag[q], lane ^ 32); Bp[q] = lane_get(Bg[q], lane ^ 32); }
        float st = hst, hs[4];
#pragma unroll
        for (int Gi = 0; Gi < 8; ++Gi) {
            const int q = Gi >> 1; const bool own = (hh == (Gi & 1));
            const float A = own ? Ag[q] : Ap[q], B = own ? Bg[q] : Bp[q];
            if (own) hs[q] = st;
            st = A * st + B;
        }
        hst = st;
        if (!is_ctx) {
            bf16_t* yr = yl + ((size_t)bl * 2048 + tile * 32) * 1024 + d;
#pragma unroll
            for (int e = 0; e < 16; ++e) { const int k = DIR ? 15 - e : e; const float hv = av[k] * hs[k >> 2] + bv[k];
                const int tok = (e & 3) + 8 * (e >> 2) + 4 * h; yr[(size_t)tok * 1024] = f2bf(hv); }
        }
    }
}

struct EpiRaw {
    static constexpr bool PERM = true;
    bf16_t* O; int ldc;
    __device__ __forceinline__ void operator()(f32x4 (&acc)[2][2][4][2], const Unit& u, int wr, int wc, int fr, int fq) const {
        const int row0 = u.pm * 256 + wr * 64 + fr, col0 = u.pn * 256 + wc * 32 + 8 * fq;
#pragma unroll
        for (int ai = 0; ai < 2; ++ai)
#pragma unroll
            for (int m = 0; m < 4; ++m) { bf16_t* rowp = O + (size_t)(row0 + ai * 128 + m * 16) * ldc + col0;
#pragma unroll
                for (int bj = 0; bj < 2; ++bj) { const f32x4 v0 = acc[ai][bj][m][0], v1 = acc[ai][bj][m][1];
                    u32x4 w; w.x = cvt_pk_bf16(v0[0], v0[1]); w.y = cvt_pk_bf16(v0[2], v0[3]); w.z = cvt_pk_bf16(v1[0], v1[1]); w.w = cvt_pk_bf16(v1[2], v1[3]);
                    *(u32x4*)(rowp + bj * 128) = w; } }
    }
};
__device__ __forceinline__ float gelu_tanh(float x) { const float y = 0.7978845608028654f * (x + 0.044715f * x * x * x); const float t = 1.f - 2.f * __builtin_amdgcn_rcpf(1.f + __expf(2.f * y)); return 0.5f * x * (1.f + t); }
struct EpiG1b {
    static constexpr bool PERM = true;
    bf16_t* y1; const bf16_t* y2; bf16_t* ylf; const bf16_t* ylb; bf16_t* gates; const float* b_gate; LAS float* xl;
    __device__ __forceinline__ void operator()(f32x4 (&acc)[2][2][4][2], const Unit& u, int wr, int wc, int fr, int fq) const {
        const int row0 = u.pm * 256 + wr * 64 + fr, c8 = wc * 32 + 8 * fq;
        if (u.pn < 8) {
            unsigned xoff = (unsigned)(wr * 64 + fr) * 16u; asm volatile("" : "+v"(xoff));
            LAS float* xb = (LAS float*)((LAS unsigned char*)xl + xoff);
            float ssq[2][4];
#pragma unroll
            for (int ai = 0; ai < 2; ++ai) {
                u32x4 ya[4][2], yb[4][2];
#pragma unroll
                for (int m = 0; m < 4; ++m)
#pragma unroll
                    for (int bj = 0; bj < 2; ++bj) { const size_t idx = (size_t)(row0 + ai * 128 + m * 16) * 2048 + u.pn * 256 + bj * 128 + c8;
                        ya[m][bj] = *(const u32x4*)(y1 + idx); yb[m][bj] = *(const u32x4*)(y2 + idx); }
#pragma unroll
                for (int m = 0; m < 4; ++m) { ssq[ai][m] = 0.f;
#pragma unroll
                    for (int bj = 0; bj < 2; ++bj) { const u32x4 a = ya[m][bj], b = yb[m][bj];
                        float yv[8] = {bflo(a.x) + bflo(b.x), bfhi(a.x) + bfhi(b.x), bflo(a.y) + bflo(b.y), bfhi(a.y) + bfhi(b.y), bflo(a.z) + bflo(b.z), bfhi(a.z) + bfhi(b.z), bflo(a.w) + bflo(b.w), bfhi(a.w) + bfhi(b.w)};
#pragma unroll
                        for (int n = 0; n < 2; ++n)
#pragma unroll
                            for (int j = 0; j < 4; ++j) { const float z = acc[ai][bj][m][n][j]; const float gv = yv[4 * n + j] * siluf_(z); acc[ai][bj][m][n][j] = gv; ssq[ai][m] += gv * gv; } }
                    ssq[ai][m] += lane_get(ssq[ai][m], (fr | (fq << 4)) ^ 16); ssq[ai][m] += lane_get(ssq[ai][m], (fr | (fq << 4)) ^ 32);
                    if (fq == 0) xb[(ai * 128 + m * 16) * 4 + wc] = ssq[ai][m]; }
            }
            LDS_FENCE(); __builtin_amdgcn_s_barrier(); asm volatile("" ::: "memory");
#pragma unroll
            for (int ai = 0; ai < 2; ++ai)
#pragma unroll
                for (int m = 0; m < 4; ++m) { const f32x4 s4 = *(const LAS f32x4*)(xb + (ai * 128 + m * 16) * 4);
                    const float rstd = __builtin_amdgcn_rsqf(((s4.x + s4.y) + (s4.z + s4.w)) * (1.f / 256.f) + 1e-5f);
#pragma unroll
                    for (int bj = 0; bj < 2; ++bj) { const size_t idx = (size_t)(row0 + ai * 128 + m * 16) * 2048 + u.pn * 256 + bj * 128 + c8;
                        const f32x4 v0 = acc[ai][bj][m][0] * rstd, v1 = acc[ai][bj][m][1] * rstd;
                        u32x4 w; w.x = cvt_pk_bf16(v0[0], v0[1]); w.y = cvt_pk_bf16(v0[2], v0[3]); w.z = cvt_pk_bf16(v1[0], v1[1]); w.w = cvt_pk_bf16(v1[2], v1[3]);
                        *(u32x4*)(y1 + idx) = w; } }
        } else if (u.pn < 12) {
#pragma unroll
            for (int ai = 0; ai < 2; ++ai) {
                u32x4 ya[4][2], yb[4][2];
#pragma unroll
                for (int m = 0; m < 4; ++m)
#pragma unroll
                    for (int bj = 0; bj < 2; ++bj) { const size_t idx = (size_t)(row0 + ai * 128 + m * 16) * 1024 + (u.pn - 8) * 256 + bj * 128 + c8;
                        ya[m][bj] = *(const u32x4*)(ylf + idx); yb[m][bj] = *(const u32x4*)(ylb + idx); }
#pragma unroll
                for (int m = 0; m < 4; ++m)
#pragma unroll
                    for (int bj = 0; bj < 2; ++bj) { const size_t idx = (size_t)(row0 + ai * 128 + m * 16) * 1024 + (u.pn - 8) * 256 + bj * 128 + c8;
                        const u32x4 a = ya[m][bj], b = yb[m][bj];
                        float yv[8] = {bflo(a.x) + bflo(b.x), bfhi(a.x) + bfhi(b.x), bflo(a.y) + bflo(b.y), bfhi(a.y) + bfhi(b.y), bflo(a.z) + bflo(b.z), bfhi(a.z) + bfhi(b.z), bflo(a.w) + bflo(b.w), bfhi(a.w) + bfhi(b.w)};
                        float o[8];
#pragma unroll
                        for (int n = 0; n < 2; ++n)
#pragma unroll
                            for (int j = 0; j < 4; ++j) o[4 * n + j] = yv[4 * n + j] * gelu_tanh(acc[ai][bj][m][n][j]);
                        u32x4 w; w.x = cvt_pk_bf16(o[0], o[1]); w.y = cvt_pk_bf16(o[2], o[3]); w.z = cvt_pk_bf16(o[4], o[5]); w.w = cvt_pk_bf16(o[6], o[7]);
                        *(u32x4*)(ylf + idx) = w; }
            }
        } else {
#pragma unroll
            for (int bj = 0; bj < 2; ++bj) { const int col = (u.pn - 12) * 256 + bj * 128 + c8;
                const f32x4 b0 = *(const f32x4*)(b_gate + col), b1 = *(const f32x4*)(b_gate + col + 4);
#pragma unroll
                for (int ai = 0; ai < 2; ++ai)
#pragma unroll
                    for (int m = 0; m < 4; ++m) { const f32x4 v0 = acc[ai][bj][m][0] + b0, v1 = acc[ai][bj][m][1] + b1;
                        u32x4 w; w.x = cvt_pk_bf16(sigmoidf_(v0[0]), sigmoidf_(v0[1])); w.y = cvt_pk_bf16(sigmoidf_(v0[2]), sigmoidf_(v0[3]));
                        w.z = cvt_pk_bf16(sigmoidf_(v1[0]), sigmoidf_(v1[1])); w.w = cvt_pk_bf16(sigmoidf_(v1[2]), sigmoidf_(v1[3]));
                        *(u32x4*)(gates + (size_t)(row0 + ai * 128 + m * 16) * 2048 + col) = w; } }
        }
    }
};
struct EpiBrS {
    static constexpr bool PERM = false;
    const bf16_t* gates; bf16_t* tmp;
    __device__ __forceinline__ void operator()(f32x4 (&acc)[2][2][4][2], const Unit& u, int wr, int wc, int fr, int fq) const {
        const int row0 = u.pm * 256 + wr * 64 + fr, col0 = u.pn * 256 + wc * 32 + 4 * fq;
#pragma unroll
        for (int ai = 0; ai < 2; ++ai) {
            u32x2 gw[4][2][2];
#pragma unroll
            for (int m = 0; m < 4; ++m)
#pragma unroll
                for (int bj = 0; bj < 2; ++bj)
#pragma unroll
                    for (int n = 0; n < 2; ++n) gw[m][bj][n] = *(const u32x2*)(gates + (size_t)(row0 + ai * 128 + m * 16) * 2048 + col0 + bj * 128 + n * 16);
#pragma unroll
            for (int m = 0; m < 4; ++m) { const size_t row = row0 + ai * 128 + m * 16;
#pragma unroll
                for (int bj = 0; bj < 2; ++bj)
#pragma unroll
                    for (int n = 0; n < 2; ++n) { const int col = col0 + bj * 128 + n * 16; const u32x2 g2 = gw[m][bj][n];
                        const f32x4 gv = (f32x4){bflo(g2.x), bfhi(g2.x), bflo(g2.y), bfhi(g2.y)};
                        const f32x4 o = gv * acc[ai][bj][m][n]; u32x2 w; w.x = cvt_pk_bf16(o[0], o[1]); w.y = cvt_pk_bf16(o[2], o[3]); *(u32x2*)(tmp + row * 1024 + col) = w; } }
        }
    }
};
struct EpiBrL {
    static constexpr bool PERM = false;
    const bf16_t* gates; const bf16_t* tmp; bf16_t* merged;
    __device__ __forceinline__ void operator()(f32x4 (&acc)[2][2][4][2], const Unit& u, int wr, int wc, int fr, int fq) const {
        const int row0 = u.pm * 256 + wr * 64 + fr, col0 = u.pn * 256 + wc * 32 + 4 * fq;
#pragma unroll
        for (int ai = 0; ai < 2; ++ai) {
            u32x2 gw[4][2][2], tw[4][2][2];
#pragma unroll
            for (int m = 0; m < 4; ++m)
#pragma unroll
                for (int bj = 0; bj < 2; ++bj)
#pragma unroll
                    for (int n = 0; n < 2; ++n) { const size_t row = row0 + ai * 128 + m * 16; const int col = col0 + bj * 128 + n * 16;
                        gw[m][bj][n] = *(const u32x2*)(gates + row * 2048 + 1024 + col); tw[m][bj][n] = *(const u32x2*)(tmp + row * 1024 + col); }
#pragma unroll
            for (int m = 0; m < 4; ++m) { const size_t row = row0 + ai * 128 + m * 16;
#pragma unroll
                for (int bj = 0; bj < 2; ++bj)
#pragma unroll
                    for (int n = 0; n < 2; ++n) { const int col = col0 + bj * 128 + n * 16; const u32x2 g2 = gw[m][bj][n], t2 = tw[m][bj][n];
                        const f32x4 gv = (f32x4){bflo(g2.x), bfhi(g2.x), bflo(g2.y), bfhi(g2.y)};
                        const f32x4 o = (f32x4){bflo(t2.x), bfhi(t2.x), bflo(t2.y), bfhi(t2.y)} + gv * acc[ai][bj][m][n];
                        u32x2 w; w.x = cvt_pk_bf16(o[0], o[1]); w.y = cvt_pk_bf16(o[2], o[3]); *(u32x2*)(merged + row * 1024 + col) = w; } }
        }
    }
};
struct EpiRes {
    static constexpr bool PERM = false;
    const float* gate; const float* bias; bf16_t* O; int bbase;
    __device__ __forceinline__ void operator()(f32x4 (&acc)[2][2][4][2], const Unit& u, int wr, int wc, int fr, int fq) const {
        const int row0 = u.pm * 256 + wr * 64 + fr, col0 = u.pn * 256 + wc * 32 + 4 * fq;
        const float* gr = gate + (size_t)(bbase + (u.pm * 256) / SEQ) * MODW;
#pragma unroll
        for (int bj = 0; bj < 2; ++bj)
#pragma unroll
            for (int n = 0; n < 2; ++n) { const int col = col0 + bj * 128 + n * 16; const f32x4 gv = *(const f32x4*)(gr + col);
                f32x4 bv = (f32x4){0.f, 0.f, 0.f, 0.f}; if (bias) bv = *(const f32x4*)(bias + col);
#pragma unroll
                for (int ai = 0; ai < 2; ++ai)
#pragma unroll
                    for (int m = 0; m < 4; ++m) { const size_t row = row0 + ai * 128 + m * 16;
                        const f32x4 o = gv * (acc[ai][bj][m][n] + bv); u32x2 w; w.x = cvt_pk_bf16(o[0], o[1]); w.y = cvt_pk_bf16(o[2], o[3]);
                        *(u32x2*)(O + row * 1024 + col) = w; } }
    }
};
struct EpiMlp1 {
    static constexpr bool PERM = true;
    bf16_t* O; const float* bias;
    __device__ __forceinline__ void operator()(f32x4 (&acc)[2][2][4][2], const Unit& u, int wr, int wc, int fr, int fq) const {
        const int row0 = u.pm * 256 + wr * 64 + fr, col0 = u.pn * 256 + wc * 32 + 8 * fq;
#pragma unroll
        for (int bj = 0; bj < 2; ++bj) { const f32x4 b0 = *(const f32x4*)(bias + col0 + bj * 128), b1 = *(const f32x4*)(bias + col0 + bj * 128 + 4);
#pragma unroll
            for (int ai = 0; ai < 2; ++ai)
#pragma unroll
                for (int m = 0; m < 4; ++m) { f32x4 v0 = acc[ai][bj][m][0] + b0, v1 = acc[ai][bj][m][1] + b1;
#pragma unroll
                    for (int j = 0; j < 4; ++j) { v0[j] = fmaxf(v0[j], 0.f); v0[j] *= v0[j]; v1[j] = fmaxf(v1[j], 0.f); v1[j] *= v1[j]; }
                    u32x4 w; w.x = cvt_pk_bf16(v0[0], v0[1]); w.y = cvt_pk_bf16(v0[2], v0[3]); w.z = cvt_pk_bf16(v1[0], v1[1]); w.w = cvt_pk_bf16(v1[2], v1[3]);
                    *(u32x4*)(O + (size_t)(row0 + ai * 128 + m * 16) * 4096 + col0 + bj * 128) = w; } }
    }
};

constexpr int PH_PER_GROUP = 11, N_PHASES = 1 + NGRP * PH_PER_GROUP;
typedef const __attribute__((address_space(4))) Params* CParamsPtr;
constexpr size_t OFF_BAR = 900096;
static_assert(OFF_BAR >= 33 * 6144 * 4 && OFF_BAR + 3456 * 4 <= OFF_WA, "barrier word placement");
#define XB_TMO      128
#define XB_XCNT(j)  (256  + 64 * (j))
#define XB_XSUB(j)  (1280 + 64 * (j))
#define XB_XGEN(j)  (2304 + 64 * (j))
#define XB_TOP      3328
#define XB_TOPGEN   3392
#define XCD_BAR_WORDS 3456
#define XB_SPIN_CAP (1u << 22)
__device__ __forceinline__ unsigned xb_ld(unsigned* p)              { return __hip_atomic_load(p, __ATOMIC_RELAXED, __HIP_MEMORY_SCOPE_AGENT); }
__device__ __forceinline__ unsigned xb_add(unsigned* p, unsigned v) { return __hip_atomic_fetch_add(p, v, __ATOMIC_RELAXED, __HIP_MEMORY_SCOPE_AGENT); }
__device__ __forceinline__ unsigned xb_xcc_id() { return (unsigned)__builtin_amdgcn_s_getreg((3 << 11) | 20) & 0xFu; }
#define XB_SPIN(cond, bar) do { unsigned _sp = 0; while (cond) { __builtin_amdgcn_s_sleep(1); \
    if ((++_sp & 255u) == 0u) { if (xb_ld(&(bar)[XB_TMO])) break; if (_sp > XB_SPIN_CAP) { atomicAdd(&(bar)[XB_TMO], 1u); break; } } } } while (0)
__device__ __forceinline__ void xcd_barrier_complete(unsigned* bar, unsigned x, unsigned G, unsigned& nloc, unsigned& nx) {
    unsigned sum, cnt, mine, sp = 0u;
    for (;;) {
        sum = 0u; cnt = 0u; mine = 0u;
#pragma unroll
        for (unsigned j = 0; j < 16; ++j) { const unsigned c = xb_ld(&bar[XB_XCNT(j)]); sum += c; cnt += (c > 0u) ? 1u : 0u; mine = (j == x) ? c : mine; }
        if (sum == G) break;
        __builtin_amdgcn_s_sleep(1);
        if ((++sp & 255u) == 0u) { if (xb_ld(&bar[XB_TMO])) break; if (sp > XB_SPIN_CAP) { atomicAdd(&bar[XB_TMO], 1u); break; } }
    }
    nloc = mine > 0u ? mine : 1u; nx = cnt > 0u ? cnt : 1u;
}
__device__ __forceinline__ void grid_bar(unsigned* bar, volatile LAS unsigned* st, unsigned G, int tid) {
    asm volatile("s_waitcnt vmcnt(0)" ::: "memory");
    __syncthreads();
    if (tid == 0) {
        __builtin_amdgcn_s_waitcnt(0);
        const unsigned x = xb_xcc_id();
        unsigned nloc = st[0], nx = st[1];
        if (nloc == 0u) { xcd_barrier_complete(bar, x, G, nloc, nx); st[0] = nloc; st[1] = nx; }
        const unsigned old = xb_add(&bar[XB_XSUB(x)], 1u);
        const unsigned gen = old / nloc;
        if (old + 1u == (gen + 1u) * nloc) {
            __builtin_amdgcn_fence(__ATOMIC_RELEASE, "agent");
            asm volatile("s_waitcnt vmcnt(0)" ::: "memory");
            const unsigned og = xb_add(&bar[XB_TOP], 1u);
            const unsigned tg = og / nx;
            if (og + 1u == (tg + 1u) * nx) xb_add(&bar[XB_TOPGEN], 1u);
            else XB_SPIN(xb_ld(&bar[XB_TOPGEN]) == tg, bar);
            __builtin_amdgcn_fence(__ATOMIC_ACQUIRE, "agent");
            xb_add(&bar[XB_XGEN(x)], 1u);
            asm volatile("s_waitcnt vmcnt(0)" ::: "memory");
        } else {
            XB_SPIN(xb_ld(&bar[XB_XGEN(x)]) == gen, bar);
            __builtin_amdgcn_fence(__ATOMIC_ACQUIRE, "agent");
            asm volatile("s_waitcnt vmcnt(0)" ::: "memory");
        }
    }
    __syncthreads();
}
constexpr int ST_OFF = LDS_BYTES - 16;
__global__ void __launch_bounds__(512) mega(Params p_arg) {
    extern __shared__ __attribute__((aligned(16))) unsigned char lds_raw[];
    LAS unsigned char* lds = (LAS unsigned char*)lds_raw;
    if (threadIdx.x == 0) { volatile LAS unsigned* st = (volatile LAS unsigned*)(lds + ST_OFF); st[0] = 0u; st[1] = 0u; (void)xb_add(&((unsigned*)(p_arg.ws + OFF_BAR))[XB_XCNT(xb_xcc_id())], 1u); }
    const int wave0 = __builtin_amdgcn_readfirstlane(threadIdx.x >> 6);
    {
        const int tid = threadIdx.x, wid = wave0, lane = tid & 63;
        phase_p0(p_arg, lds, blockIdx.x, gridDim.x, tid, wid, lane);
    }
    if (p_arg.ws == nullptr) cg::this_grid().sync();
    grid_bar((unsigned*)(p_arg.ws + OFF_BAR), (volatile LAS unsigned*)(lds + ST_OFF), (unsigned)gridDim.x, (int)threadIdx.x);
#ifndef REPEAT_Q
#define REPEAT_Q -1
#endif
    for (int ph = 1; ph < N_PHASES; ++ph) {
        for (int rep = 0; rep < (((ph - 1) % PH_PER_GROUP == REPEAT_Q) ? 2 : 1); ++rep) {
        if ((ph - 1) % PH_PER_GROUP == 0 && ph > 1) continue;
        int wv_ = wave0, wg_ = blockIdx.x; asm volatile("" : "+s"(wv_), "+s"(wg_));
        int lane_; asm volatile("v_mbcnt_lo_u32_b32 %0, -1, 0\n\tv_mbcnt_hi_u32_b32 %0, -1, %0" : "=v"(lane_));
        int tid_ = wv_ * 64 + lane_;
        const int tid = tid_, wid = wv_, lane = tid & 63;
        const int wg = wg_, G = gridDim.x;
        const int gw = wg * 8 + wid, NGW = G * 8;
        pg8::StaticOrder S;
#if defined(__HIP_DEVICE_COMPILE__)
        CParamsPtr gp = (CParamsPtr)__builtin_amdgcn_kernarg_segment_ptr();
        asm volatile("" : "+s"(gp) :: "memory");
        const Params p = *gp;
#else
        const Params p = p_arg;
#endif
        if (ph > 1 || rep > 0) grid_bar((unsigned*)(p.ws + OFF_BAR), (volatile LAS unsigned*)(lds + ST_OFF), (unsigned)G, tid);
#ifdef EXTRA_BARRIERS
        for (int xb = 0; xb < EXTRA_BARRIERS; ++xb) grid_bar((unsigned*)(p.ws + OFF_BAR), (volatile LAS unsigned*)(lds + ST_OFF), (unsigned)G, tid);
#endif
        const int g = (ph - 1) / PH_PER_GROUP, q = (ph - 1) % PH_PER_GROUP;
        unsigned char* ws = p.ws;
        const float* mod = (const float*)(ws + OFF_MOD);
        switch (q) {
        case 0: phase_ln0(p, g, gw, NGW, lane); break;
        case 1: { pg8::Gemm gm{(const bf16_t*)(ws + OFF_H0), (const bf16_t*)(ws + OFF_WA), RG, NA, 1024}; S.init(RG, NA, G, wg);
                  EpiRaw E{(bf16_t*)(ws + OFF_RAW), NA}; pg8::gemm_phase(lds, gm, S, E, tid); } break;
        case 2: phase_conv(p, lds, wg, G, tid); break;
        case 3: {
#ifdef PROBE_SSD
            for (int item = wg; item < BG * 8 * 2; item += G) { if (item & 1) ssd_item<1, PROBE_SSD>(p, item >> 1, lds, wid, lane); else ssd_item<0, PROBE_SSD>(p, item >> 1, lds, wid, lane); }
#endif
            for (int item = wg; item < BG * 8 * 2; item += G) { if (item & 1) ssd_item<1>(p, item >> 1, lds, wid, lane); else ssd_item<0>(p, item >> 1, lds, wid, lane); }
            int l2; asm volatile("v_mbcnt_lo_u32_b32 %0, -1, 0\n\tv_mbcnt_hi_u32_b32 %0, -1, %0" : "=v"(l2));
            int t2 = wv_ * 64 + l2;
            const int wid2 = wv_, lane2 = t2 & 63;
            if (wid2 < 4) for (int cu = wg; cu < BG * 8 * 2; cu += G) { const int it = (cu >> 1) * 4 + wid2; if (cu & 1) lru_item<1>(p, it, lane2); else lru_item<0>(p, it, lane2); }
        } break;
        case 4: { pg8::Gemm gm{(const bf16_t*)(ws + OFF_H0) + (size_t)CGR * 1024, (const bf16_t*)(ws + OFF_WB), TG, NBC, 1024}; S.init(TG, NBC, G, wg);
                  EpiG1b E{(bf16_t*)(ws + OFF_Y1), (const bf16_t*)(ws + OFF_Y2), (bf16_t*)(ws + OFF_YLF), (const bf16_t*)(ws + OFF_YLB), (bf16_t*)(ws + OFF_GATES), p.b_gate, (LAS float*)(lds + XCH_OFF)};
                  pg8::gemm_phase(lds, gm, S, E, tid); } break;
        case 5: { S.init(TG, 1024, G, wg);
                  { pg8::Gemm gm{(const bf16_t*)(ws + OFF_Y1), (const bf16_t*)(ws + OFF_WBRS), TG, 1024, 2048};
                    EpiBrS E{(const bf16_t*)(ws + OFF_GATES), (bf16_t*)(ws + OFF_TMP)}; pg8::gemm_phase(lds, gm, S, E, tid); }
                  { pg8::Gemm gm{(const bf16_t*)(ws + OFF_YLF), (const bf16_t*)(ws + OFF_WBRL), TG, 1024, 1024};
                    EpiBrL E{(const bf16_t*)(ws + OFF_GATES), (const bf16_t*)(ws + OFF_TMP), (bf16_t*)(ws + OFF_MERGED)}; pg8::gemm_phase(lds, gm, S, E, tid); } } break;
        case 6: { pg8::Gemm gm{(const bf16_t*)(ws + OFF_MERGED), (const bf16_t*)(ws + OFF_WOUT), TG, 1024, 1024}; S.init(TG, 1024, G, wg);
                  EpiRes E{mod + 2 * DM, nullptr, (bf16_t*)(ws + OFF_BR1), g * BG}; pg8::gemm_phase(lds, gm, S, E, tid); } break;
        case 7: phase_ln1(p, g, gw, NGW, lane); break;
        case 8: { pg8::Gemm gm{(const bf16_t*)(ws + OFF_H1), (const bf16_t*)(ws + OFF_W1), TG, 4096, 1024}; S.init(TG, 4096, G, wg);
                  EpiMlp1 E{(bf16_t*)(ws + OFF_HID), p.b_mlp1}; pg8::gemm_phase(lds, gm, S, E, tid); } break;
        case 9: { pg8::Gemm gm{(const bf16_t*)(ws + OFF_HID), (const bf16_t*)(ws + OFF_W2), TG, 1024, 4096}; S.init(TG, 1024, G, wg);
                  EpiRes E{mod + 5 * DM, p.b_mlp2, (bf16_t*)(ws + OFF_BR2), g * BG}; pg8::gemm_phase(lds, gm, S, E, tid); } break;
        case 10: phase_ln2(p, g, gw, NGW, lane); if (g + 1 < NGRP) phase_ln0(p, g + 1, gw, NGW, lane); break;
        }
        }
    }
}

extern "C" void kernel_launch(void* const* d_in, const int* in_sizes, int n_in, void* d_out, int out_size, void* d_ws, size_t ws_size, hipStream_t stream) {
    static int grid = 0;
    if (grid == 0) {
        if (n_in != 32 || ws_size < WS_END) { fprintf(stderr, "kernel_launch: unexpected n_in %d / ws_size %zu (need %zu)\n", n_in, ws_size, (size_t)WS_END); grid = -1; return; }
        if (hipFuncSetAttribute((const void*)mega, hipFuncAttributeMaxDynamicSharedMemorySize, LDS_BYTES) != hipSuccess) { fprintf(stderr, "kernel_launch: hipFuncSetAttribute failed\n"); grid = -1; return; }
        int dev = 0, cus = 0, per_cu = 0;
        hipGetDevice(&dev); hipDeviceGetAttribute(&cus, hipDeviceAttributeMultiprocessorCount, dev);
        hipOccupancyMaxActiveBlocksPerMultiprocessor(&per_cu, (const void*)mega, 512, LDS_BYTES);
        if (per_cu < 1) { fprintf(stderr, "kernel_launch: occupancy query says %d blocks per CU\n", per_cu); per_cu = 1; }
        (void)hipGetLastError();
        grid = cus;
    }
    if (grid < 0) return;
    Params p{};
    const float** pp = (const float**)&p;
    for (int i = 0; i < 32; ++i) pp[i] = (const float*)d_in[i];
    p.out = (float*)d_out; p.ws = (unsigned char*)d_ws;
    if (hipMemsetAsync((unsigned char*)d_ws + OFF_BAR, 0, XCD_BAR_WORDS * 4, stream) != hipSuccess) { fprintf(stderr, "kernel_launch: memset of the barrier word failed\n"); return; }
    void* args[] = {&p};
    hipError_t e = hipLaunchCooperativeKernel((const void*)mega, dim3(grid), dim3(512), args, LDS_BYTES, stream);
    if (e != hipSuccess) fprintf(stderr, "kernel_launch: cooperative launch failed: %s (grid %d)\n", hipGetErrorString(e), grid);
}
```

```cpp
#include <hip/hip_runtime.h>
#include <hip/hip_cooperative_groups.h>
#include <cstdio>
namespace cg = cooperative_groups;
namespace pg8 {
#define PG8_LAS __attribute__((address_space(3)))
typedef unsigned short bf16_t;
typedef short bf16x8 __attribute__((ext_vector_type(8)));
typedef float f32x4 __attribute__((ext_vector_type(4)));
typedef unsigned u32x4 __attribute__((ext_vector_type(4)));
constexpr int BM = 256, BK = 64, HALF = 128, HTB = HALF * BK * 2  , STAGE_BYTES = 8 * HTB, NXCD = 8, WGM = 8;
__host__ __device__ __forceinline__ int lds_byte(int r, int c) { const int st = (r >> 4) * 2 + (c >> 5), rr = r & 15, cc = c & 31, ob = rr * 64 + cc * 2; return st * 1024 + (ob ^ (((ob >> 9) & 1) << 5)); }
__host__ __device__ __forceinline__ void stage_rc(int b, int& R, int& C) { const int st = b / 1024, sb = b % 1024, swz = sb ^ (((sb >> 9) & 1) << 5); R = (st >> 1) * 16 + swz / 64; C = (st & 1) * 32 + (swz % 64) / 2; }
__host__ __device__ __forceinline__ int perm32(int rho) { const int n = rho >> 4, i = rho & 15; return 8 * (i >> 2) + 4 * n + (i & 3); }

struct Unit { int pm, pn; };
struct Gemm { const bf16_t* A; const bf16_t* Bt; int M, N, K; };
struct StaticOrder {
    int nM, nN, nwg, G, c;
    __host__ __device__ void init(int M, int N, int G_, int c_) { nM = M / BM; nN = N / BM; nwg = nM * nN; G = G_; c = c_; }
    __host__ __device__ bool next(int i, Unit& u) const {
        const long L = (long)i * G + c; if (L >= nwg) return false;
        int wgid = (int)L; { const int q = nwg / NXCD, r = nwg % NXCD, xcd = wgid % NXCD, off = wgid / NXCD; wgid = (xcd < r ? xcd * (q + 1) : r * (q + 1) + (xcd - r) * q) + off; }
        const int nig = WGM * nN, gid = wgid / nig, fm = gid * WGM, gsz = (nM - fm) < WGM ? (nM - fm) : WGM;
        u.pm = fm + ((wgid % nig) % gsz); u.pn = (wgid % nig) / gsz; return true;
    }
    __device__ __forceinline__ void a_ready(const Unit&) const {}
    __device__ __forceinline__ void done(const Unit&) const {}
};
__device__ __forceinline__ unsigned cvt_pk_bf16(float lo, float hi) { unsigned r; asm volatile("s_nop 0\n\tv_cvt_pk_bf16_f32 %0, %1, %2\n\ts_nop 1" : "=v"(r) : "v"(lo), "v"(hi)); return r; }
template <class Epi, class Sched>
__device__ __forceinline__ void gemm_phase(PG8_LAS unsigned char* lds, const Gemm g, const Sched& S, const Epi& E, int tid_in) {
    int tid_ = tid_in; asm volatile("" : "+v"(tid_));
    const int tid = tid_, wid = __builtin_amdgcn_readfirstlane(tid >> 6), lane = tid & 63, wr = wid >> 2, wc = wid & 3, fr = lane & 15, fq = lane >> 4;
    const int K = g.K, nt = K / BK;
    unsigned voffA[2], voffB[2];
#pragma unroll
    for (int i = 0; i < 2; ++i) { int R, C; stage_rc(tid * 16 + i * 8192, R, C); const int Rb = Epi::PERM ? ((R & ~31) + perm32(R & 31)) : R;
        voffA[i] = (unsigned)(R * K + C) * 2u; voffB[i] = (unsigned)(Rb * K + C) * 2u; }
    const size_t kstep = (size_t)(BK * 2);
    const size_t hstep = (size_t)HALF * K * 2;
    const size_t tstep = 2 * hstep;
    const unsigned ldsw = (unsigned)wid * 1024u;
    const int aoff = lds_byte(wr * 64 + fr, fq * 8), boff = lds_byte(wc * 32 + fr, fq * 8);
#define PG8_SA(b, h) (((b) * 2 + (h)) * HTB)
#define PG8_SB(b, h) ((4 + (b) * 2 + (h)) * HTB)
#define PG8_STAGE(bufoff, gbase, voff) do { _Pragma("unroll") for (int _i = 0; _i < 2; ++_i) \
        __builtin_amdgcn_global_load_lds((const unsigned*)((const char*)(gbase) + (voff)[_i]), (PG8_LAS unsigned*)(lds + (bufoff) + ldsw + _i * 8192), 16, 0, 0); } while (0)
#define PG8_LDA(dst, b, h) do { _Pragma("unroll") for (int m = 0; m < 4; ++m) _Pragma("unroll") for (int k = 0; k < 2; ++k) dst[m][k] = *(const PG8_LAS bf16x8*)(lds + PG8_SA(b, h) + aoff + m * 2048 + k * 1024); } while (0)
#define PG8_LDB(dst, b, h) do { _Pragma("unroll") for (int n = 0; n < 2; ++n) _Pragma("unroll") for (int k = 0; k < 2; ++k) dst[n][k] = *(const PG8_LAS bf16x8*)(lds + PG8_SB(b, h) + boff + n * 2048 + k * 1024); } while (0)
#define PG8_MMA(ai, bj, At, Bt) do { __builtin_amdgcn_s_setprio(1); _Pragma("unroll") for (int m = 0; m < 4; ++m) _Pragma("unroll") for (int n = 0; n < 2; ++n) _Pragma("unroll") for (int k = 0; k < 2; ++k) \
        acc[ai][bj][m][n] = __builtin_amdgcn_mfma_f32_16x16x32_bf16(Bt[n][k], At[m][k], acc[ai][bj][m][n], 0, 0, 0); __builtin_amdgcn_s_setprio(0); } while (0)
#define PG8_WAIT_V(n) asm volatile("s_waitcnt vmcnt(" #n ")" ::: "memory")
#define PG8_WAIT_L(n) asm volatile("s_waitcnt lgkmcnt(" #n ")" ::: "memory")
#define PG8_BAR __builtin_amdgcn_s_barrier()
#define PG8_SCHED __builtin_amdgcn_sched_barrier(0)
    Unit cur, nxt; int ui = 0;
    if (!S.next(0, cur)) return;
    f32x4 acc[2][2][4][2];
#pragma unroll
    for (int a = 0; a < 2; ++a)
#pragma unroll
        for (int b = 0; b < 2; ++b)
#pragma unroll
            for (int m = 0; m < 4; ++m)
#pragma unroll
                for (int n = 0; n < 2; ++n) acc[a][b][m][n] = (f32x4){0.f, 0.f, 0.f, 0.f};
    bf16x8 At[4][2], B0[2][2], B1[2][2];
    const char* cA = (const char*)g.A + (size_t)cur.pm * tstep; const char* cB = (const char*)g.Bt + (size_t)cur.pn * tstep;
    S.a_ready(cur);
    PG8_STAGE(PG8_SB(0, 0), cB, voffB); PG8_STAGE(PG8_SA(0, 0), cA, voffA); PG8_STAGE(PG8_SB(0, 1), cB + hstep, voffB); PG8_STAGE(PG8_SA(0, 1), cA + hstep, voffA);
    if (wr == 1) PG8_BAR;
    PG8_WAIT_V(4); PG8_BAR;
    PG8_STAGE(PG8_SB(1, 0), cB + kstep, voffB); PG8_STAGE(PG8_SA(1, 0), cA + kstep, voffA); PG8_STAGE(PG8_SB(1, 1), cB + hstep + kstep, voffB);
    PG8_WAIT_V(6); PG8_BAR;
    for (;;) {
        const bool has_next = S.next(ui + 1, nxt);
        const char* nA = has_next ? (const char*)g.A + (size_t)nxt.pm * tstep : cA; const char* nB = has_next ? (const char*)g.Bt + (size_t)nxt.pn * tstep : cB;
        for (int t = 0; t < nt; t += 2) {
            const bool last = (t == nt - 2);
            const char* a1 = cA + (size_t)(t + 1) * kstep;
            const char* a2 = last ? nA : cA + (size_t)(t + 2) * kstep; const char* b2 = last ? nB : cB + (size_t)(t + 2) * kstep;
            const char* a3 = a2 + kstep; const char* b3 = b2 + kstep;
            if (last && has_next) S.a_ready(nxt);
            PG8_LDB(B0, 0, 0); PG8_SCHED; PG8_LDA(At, 0, 0); PG8_STAGE(PG8_SA(1, 1), a1 + hstep, voffA);
            PG8_WAIT_L(8); PG8_BAR; PG8_WAIT_L(0); PG8_MMA(0, 0, At, B0); PG8_BAR; PG8_SCHED;
            PG8_LDB(B1, 0, 1); PG8_STAGE(PG8_SB(0, 0), b2, voffB);
            PG8_BAR; PG8_WAIT_L(0); PG8_MMA(0, 1, At, B1); PG8_BAR;
            PG8_LDA(At, 0, 1); PG8_STAGE(PG8_SA(0, 0), a2, voffA);
            PG8_BAR; PG8_WAIT_L(0); PG8_MMA(1, 0, At, B0); PG8_BAR; PG8_SCHED;
            PG8_STAGE(PG8_SB(0, 1), b2 + hstep, voffB);
            PG8_WAIT_V(6); PG8_BAR; PG8_MMA(1, 1, At, B1); PG8_BAR;
            PG8_LDB(B0, 1, 0); PG8_SCHED; PG8_LDA(At, 1, 0); PG8_STAGE(PG8_SA(0, 1), a2 + hstep, voffA);
            PG8_WAIT_L(8); PG8_BAR; PG8_WAIT_L(0); PG8_MMA(0, 0, At, B0); PG8_BAR; PG8_SCHED;
            PG8_LDB(B1, 1, 1); PG8_STAGE(PG8_SB(1, 0), b3, voffB);
            PG8_BAR; PG8_WAIT_L(0); PG8_MMA(0, 1, At, B1); PG8_BAR;
            PG8_LDA(At, 1, 1); PG8_STAGE(PG8_SA(1, 0), a3, voffA);
            PG8_BAR; PG8_WAIT_L(0); PG8_MMA(1, 0, At, B0); PG8_BAR; PG8_SCHED;
            PG8_STAGE(PG8_SB(1, 1), b3 + hstep, voffB);
            PG8_WAIT_V(6); PG8_BAR; PG8_MMA(1, 1, At, B1); PG8_BAR;
        }
        E(acc, cur, wr, wc, fr, fq);
        if (!has_next) break;
#pragma unroll
        for (int a = 0; a < 2; ++a)
#pragma unroll
            for (int b = 0; b < 2; ++b)
#pragma unroll
                for (int m = 0; m < 4; ++m)
#pragma unroll
                    for (int n = 0; n < 2; ++n) acc[a][b][m][n] = (f32x4){0.f, 0.f, 0.f, 0.f};
        cur = nxt; cA = nA; cB = nB; ++ui;
    }
    PG8_WAIT_V(0);
    if (wr == 0) PG8_BAR;
    PG8_BAR;
#undef PG8_SA
#undef PG8_SB
#undef PG8_STAGE
#undef PG8_LDA
#undef PG8_LDB
#undef PG8_MMA
#undef PG8_WAIT_V
#undef PG8_WAIT_L
#undef PG8_BAR
#undef PG8_SCHED
}
}

using pg8::bf16_t; using pg8::bf16x8; using pg8::f32x4; using pg8::u32x4; using pg8::cvt_pk_bf16; using pg8::Unit;
typedef float f32x16 __attribute__((ext_vector_type(16)));
typedef unsigned u32x2 __attribute__((ext_vector_type(2)));
typedef float f32x2 __attribute__((ext_vector_type(2)));
#define LAS __attribute__((address_space(3)))

constexpr int DM = 1024, NBATCH = 32, SEQ = 2048, CTXL = 256;
constexpr int NGRP = 2, BG = NBATCH / NGRP;
constexpr int TG = BG * SEQ, CGR = BG * CTXL, RG = CGR + TG;
constexpr int NA = 5376, NBC = 5120;
constexpr int MODW = 6 * DM;
constexpr float ALPHA = 1.189207115002721f;
constexpr int LDS_BYTES = 163840;
constexpr int XCH_OFF = 131072;

constexpr size_t OFF_MOD = 0;
constexpr size_t OFF_WA = 1048576;
constexpr size_t OFF_WB = OFF_WA + (size_t)NA * DM * 2;
constexpr size_t OFF_WBRS = OFF_WB + (size_t)NBC * DM * 2;
constexpr size_t OFF_WBRL = OFF_WBRS + (size_t)1024 * 2048 * 2;
constexpr size_t OFF_WOUT = OFF_WBRL + (size_t)1024 * 1024 * 2;
constexpr size_t OFF_W1 = OFF_WOUT + (size_t)1024 * 1024 * 2;
constexpr size_t OFF_W2 = OFF_W1 + (size_t)4096 * 1024 * 2;
constexpr size_t OFF_WG = OFF_W2 + (size_t)4096 * 1024 * 2;
constexpr size_t OFF_H0 = 51380224;
constexpr size_t OFF_A = OFF_H0 + (size_t)RG * DM * 2;
constexpr size_t SZ_A = 402653184;
constexpr size_t OFF_B = OFF_A + SZ_A;
constexpr size_t OFF_RAW = OFF_A;
constexpr size_t OFF_Y1 = OFF_A, OFF_Y2 = OFF_A + 134217728, OFF_YLF = OFF_A + 268435456, OFF_YLB = OFF_A + 335544320;
constexpr size_t OFF_X1 = OFF_A, OFF_H1 = OFF_A + 134217728, OFF_BR1 = OFF_A + 268435456;
constexpr size_t OFF_XT = OFF_B;
constexpr size_t OFF_BM = OFF_XT + (size_t)RG * 2048 * 2;
constexpr size_t OFF_BT = OFF_BM + (size_t)RG * 1024 * 2;
constexpr size_t OFF_CM = OFF_BT + (size_t)RG * 1024 * 2;
constexpr size_t OFF_U = OFF_CM + (size_t)RG * 1024 * 2;
constexpr size_t OFF_DT = OFF_U + (size_t)RG * 1024 * 2;
constexpr size_t WS_END = OFF_DT + (size_t)RG * 64 * 4;
constexpr size_t OFF_GATES = OFF_B, OFF_TMP = OFF_B + 134217728, OFF_MERGED = OFF_B + 268435456, OFF_HID = OFF_B, OFF_BR2 = OFF_B + 268435456;
static_assert(OFF_WG + 1048576 <= OFF_H0, "weights overflow");
static_assert(WS_END <= 1073741824ull, "workspace too large");

struct Params {
    const float *x, *c, *ctx, *c_ctx, *w_mod, *b_mod, *w_in, *b_gate, *ssd_conv_w, *ssd_conv_b, *ssd_dt_bias, *ssd_a_log, *ssd_d, *ssd_norm_w,
        *lru_conv_w, *lru_conv_b, *lru_wa, *lru_ba, *lru_wi, *lru_bi, *lru_lambda, *w_br_ssd, *w_br_lru, *w_out, *ln1_g, *ln1_b, *w_mlp1, *b_mlp1,
        *w_mlp2, *b_mlp2, *ln2_g, *ln2_b;
    float* out; unsigned char* ws;
};

__device__ __forceinline__ float bf2f(unsigned short b) { return __uint_as_float(((unsigned)b) << 16); }
__device__ __forceinline__ float bflo(unsigned w) { return __uint_as_float(w << 16); }
__device__ __forceinline__ float bfhi(unsigned w) { return __uint_as_float(w & 0xffff0000u); }
__device__ __forceinline__ unsigned short f2bf(float f) { return (unsigned short)(cvt_pk_bf16(f, 0.f) & 0xffffu); }
__device__ __forceinline__ float log1p_small(float e) { return e < 0.03f ? e * (1.f - e * (0.5f - e * (0.33333334f - 0.25f * e))) : __logf(1.f + e); }
__device__ __forceinline__ float sigmoidf_(float x) { return __builtin_amdgcn_rcpf(1.f + __expf(-x)); }
__device__ __forceinline__ float siluf_(float x) { return x * sigmoidf_(x); }
__device__ __forceinline__ float lane_get(float v, int src_lane) { return __int_as_float(__builtin_amdgcn_ds_bpermute(src_lane << 2, __float_as_int(v))); }
__device__ __forceinline__ float wave_sum(float v, int lane) {
#pragma unroll
    for (int o = 1; o < 64; o <<= 1) v += lane_get(v, lane ^ o);
    return v;
}
#define LDS_FENCE() asm volatile("s_waitcnt lgkmcnt(0)" ::: "memory")
__device__ __forceinline__ f32x16 mfma32(bf16x8 a, bf16x8 b, f32x16 c) { return __builtin_amdgcn_mfma_f32_32x32x16_bf16(a, b, c, 0, 0, 0); }
__device__ __forceinline__ bf16x8 pack_acc(const f32x16& v, int s) {
    u32x4 w;
    if (s == 0) { w.x = cvt_pk_bf16(v[0], v[1]); w.y = cvt_pk_bf16(v[2], v[3]); w.z = cvt_pk_bf16(v[4], v[5]); w.w = cvt_pk_bf16(v[6], v[7]); }
    else { w.x = cvt_pk_bf16(v[8], v[9]); w.y = cvt_pk_bf16(v[10], v[11]); w.z = cvt_pk_bf16(v[12], v[13]); w.w = cvt_pk_bf16(v[14], v[15]); }
    return __builtin_bit_cast(bf16x8, w);
}
__device__ __forceinline__ bf16x8 ld8(const bf16_t* p) { return *(const bf16x8*)p; }
__device__ __forceinline__ bf16x8 ld44(const bf16_t* p) {
    u32x2 lo = *(const u32x2*)p, hi = *(const u32x2*)(p + 8); u32x4 w; w.x = lo.x; w.y = lo.y; w.z = hi.x; w.w = hi.y; return __builtin_bit_cast(bf16x8, w);
}

__device__ __forceinline__ void tr_item(const float* W, int ldw, int col0, const float* kscale, bf16_t* WT, int K, int row0, LAS float* scr, int item, int nblk, int lane) {
    const int kb = item / nblk, nb = item % nblk, k0 = 64 * kb, n0 = 32 * nb;
#pragma unroll 8
    for (int i = 0; i < 32; ++i) { const int kk = 2 * i + (lane >> 5); float v = W[(size_t)(k0 + kk) * ldw + col0 + n0 + (lane & 31)]; if (kscale) v *= kscale[k0 + kk]; scr[kk * 33 + (lane & 31)] = v; }
    LDS_FENCE();
    const int c = lane & 7;
#pragma unroll
    for (int j = 0; j < 4; ++j) { const int n = (lane >> 3) + 8 * j; const LAS float* s = scr + (8 * c) * 33 + n;
        u32x4 o; o.x = cvt_pk_bf16(s[0 * 33], s[1 * 33]); o.y = cvt_pk_bf16(s[2 * 33], s[3 * 33]); o.z = cvt_pk_bf16(s[4 * 33], s[5 * 33]); o.w = cvt_pk_bf16(s[6 * 33], s[7 * 33]);
        *(u32x4*)(WT + (size_t)(row0 + n0 + n) * K + k0 + 8 * c) = o; }
    LDS_FENCE();
}
__device__ __forceinline__ void tr_matrix(const float* W, int ldw, int col0, int K, int N, const float* kscale, bf16_t* WT, int row0, LAS float* scr, int& base, int gw, int NGW, int lane) {
    const int nblk = N / 32, nitems = (K / 64) * nblk;
    int first = (gw - (base % NGW) + NGW) % NGW;
    for (int it = first; it < nitems; it += NGW) tr_item(W, ldw, col0, kscale, WT, K, row0, scr, it, nblk, lane);
    base += nitems;
}

__device__ __forceinline__ void phase_p0(const Params& p, LAS unsigned char* lds, int wg, int G, int tid, int wid, int lane) {
    float* mod = (float*)(p.ws + OFF_MOD);
    if (wg < 96) {
        LAS float* s = (LAS float*)lds;
        for (int idx = tid; idx < 33 * 1024; idx += 512) { const int b = idx >> 10, k = idx & 1023; const float v = (b < 32) ? p.c[b * 1024 + k] : p.c_ctx[k]; s[idx] = siluf_(v); }
        __syncthreads();
        const int col = wg * 64 + lane;
        float acc[33];
#pragma unroll
        for (int b = 0; b < 33; ++b) acc[b] = 0.f;
        float nw[8];
#pragma unroll
        for (int i = 0; i < 8; ++i) nw[i] = p.w_mod[(size_t)(wid * 128 + i) * MODW + col];
        for (int k = wid * 128; k < wid * 128 + 128; k += 8) {
            float w[8];
#pragma unroll
            for (int i = 0; i < 8; ++i) w[i] = nw[i];
            if (k + 8 < wid * 128 + 128) {
#pragma unroll
                for (int i = 0; i < 8; ++i) nw[i] = p.w_mod[(size_t)(k + 8 + i) * MODW + col]; }
#pragma unroll
            for (int b = 0; b < 33; ++b) { const f32x4 sv = *(const LAS f32x4*)(s + b * 1024 + k), sw = *(const LAS f32x4*)(s + b * 1024 + k + 4);
                acc[b] += (sv.x * w[0] + sv.y * w[1] + sv.z * w[2] + sv.w * w[3]) + (sw.x * w[4] + sw.y * w[5] + sw.z * w[6] + sw.w * w[7]); }
        }
        __syncthreads();
        LAS float* part = (LAS float*)lds;
#pragma unroll
        for (int b = 0; b < 33; ++b) part[(wid * 33 + b) * 64 + lane] = acc[b];
        __syncthreads();
        for (int idx = tid; idx < 33 * 64; idx += 512) { const int b = idx >> 6, l = idx & 63; float sum = 0.f;
#pragma unroll
            for (int w = 0; w < 8; ++w) sum += part[(w * 33 + b) * 64 + l];
            mod[b * MODW + wg * 64 + l] = sum + p.b_mod[wg * 64 + l]; }
        __syncthreads();
        return;
    }
    LAS float* scr = (LAS float*)(lds + wid * 8448);
    const int gw = (wg - 96) * 8 + wid, NGW = (G - 96) * 8; int base = 0;
    bf16_t* WA = (bf16_t*)(p.ws + OFF_WA); bf16_t* WB = (bf16_t*)(p.ws + OFF_WB);
    tr_matrix(p.w_in, 10304, 0, 1024, 3072, nullptr, WA, 0, scr, base, gw, NGW, lane);
    tr_matrix(p.w_in, 10304, 4160, 1024, 1024, nullptr, WA, 3072, scr, base, gw, NGW, lane);
    tr_matrix(p.w_in, 10304, 3136, 1024, 1024, nullptr, WA, 4096, scr, base, gw, NGW, lane);
    tr_matrix(p.w_in, 10304, 3072, 1024, 64, nullptr, WA, 5120, scr, base, gw, NGW, lane);
    tr_matrix(p.w_in, 10304, 5184, 1024, 5120, nullptr, WB, 0, scr, base, gw, NGW, lane);
    tr_matrix(p.w_br_ssd, 1024, 0, 2048, 1024, p.ssd_norm_w, (bf16_t*)(p.ws + OFF_WBRS), 0, scr, base, gw, NGW, lane);
    tr_matrix(p.w_br_lru, 1024, 0, 1024, 1024, nullptr, (bf16_t*)(p.ws + OFF_WBRL), 0, scr, base, gw, NGW, lane);
    tr_matrix(p.w_out, 1024, 0, 1024, 1024, nullptr, (bf16_t*)(p.ws + OFF_WOUT), 0, scr, base, gw, NGW, lane);
    tr_matrix(p.w_mlp1, 4096, 0, 1024, 4096, nullptr, (bf16_t*)(p.ws + OFF_W1), 0, scr, base, gw, NGW, lane);
    tr_matrix(p.w_mlp2, 1024, 0, 4096, 1024, nullptr, (bf16_t*)(p.ws + OFF_W2), 0, scr, base, gw, NGW, lane);
    bf16_t* WGt = (bf16_t*)(p.ws + OFF_WG);
    for (int m = 0; m < 16; ++m) {
        tr_matrix(p.lru_wa + (size_t)m * 16384, 128, 0, 128, 128, nullptr, WGt + (size_t)(m * 2 + 0) * 16384, 0, scr, base, gw, NGW, lane);
        tr_matrix(p.lru_wi + (size_t)m * 16384, 128, 0, 128, 128, nullptr, WGt + (size_t)(m * 2 + 1) * 16384, 0, scr, base, gw, NGW, lane);
    }
    for (int i = (wg - 96) * 512 + tid; i < 192 * 1024 / 8; i += (G - 96) * 512) *(u32x4*)(WA + (size_t)5184 * 1024 + (size_t)i * 8) = (u32x4){0u, 0u, 0u, 0u};
}

__device__ __forceinline__ const float* ln0_src(const Params& p, int g, int row) {
    return (row < CGR) ? p.ctx + ((size_t)g * CGR + row) * DM : p.x + ((size_t)g * TG + (row - CGR)) * DM;
}
__device__ __forceinline__ void phase_ln0(const Params& p, int g, int gw, int NGW, int lane) {
    const float* mod = (const float*)(p.ws + OFF_MOD); bf16_t* h0 = (bf16_t*)(p.ws + OFF_H0);
    f32x4 nx[4];
    if (gw < RG) { const float* src = ln0_src(p, g, gw);
#pragma unroll
        for (int j = 0; j < 4; ++j) nx[j] = *(const f32x4*)(src + 4 * lane + 256 * j); }
    for (int row = gw; row < RG; row += NGW) {
        const int mrow = (row < CGR) ? 32 : g * BG + (row - CGR) / SEQ;
        const float* sh = mod + (size_t)mrow * MODW; const float* sc = sh + DM;
        f32x4 v[4]; float s = 0.f;
#pragma unroll
        for (int j = 0; j < 4; ++j) { v[j] = nx[j]; s += (v[j].x + v[j].y) + (v[j].z + v[j].w); }
        if (row + NGW < RG) { const float* src = ln0_src(p, g, row + NGW);
#pragma unroll
            for (int j = 0; j < 4; ++j) nx[j] = *(const f32x4*)(src + 4 * lane + 256 * j); }
        const float mean = wave_sum(s, lane) * (1.f / DM); float s2 = 0.f;
#pragma unroll
        for (int j = 0; j < 4; ++j) { v[j] = v[j] - mean; s2 += (v[j].x * v[j].x + v[j].y * v[j].y) + (v[j].z * v[j].z + v[j].w * v[j].w); }
        const float rstd = __builtin_amdgcn_rsqf(wave_sum(s2, lane) * (1.f / DM) + 1e-6f);
#pragma unroll
        for (int j = 0; j < 4; ++j) { const int col = 4 * lane + 256 * j; const f32x4 a = *(const f32x4*)(sc + col), b = *(const f32x4*)(sh + col);
            const f32x4 o = v[j] * rstd * (a + 1.f) + b; u32x2 w; w.x = cvt_pk_bf16(o.x, o.y); w.y = cvt_pk_bf16(o.z, o.w);
            *(u32x2*)(h0 + (size_t)row * DM + col) = w; }
    }
}
__device__ __forceinline__ void phase_ln1(const Params& p, int g, int gw, int NGW, int lane) {
    const float* mod = (const float*)(p.ws + OFF_MOD); float* x1 = (float*)(p.ws + OFF_X1); bf16_t* h1 = (bf16_t*)(p.ws + OFF_H1);
    const float* xbase = p.x + (size_t)g * TG * DM; const bf16_t* brbase = (const bf16_t*)(p.ws + OFF_BR1);
    f32x4 gaH[4], beH[4];
#pragma unroll
    for (int j = 0; j < 4; ++j) { gaH[j] = *(const f32x4*)(p.ln1_g + 4 * lane + 256 * j); beH[j] = *(const f32x4*)(p.ln1_b + 4 * lane + 256 * j); }
    f32x4 nx[4]; u32x2 nb[4];
    if (gw < TG) {
#pragma unroll
        for (int j = 0; j < 4; ++j) { nx[j] = *(const f32x4*)(xbase + (size_t)gw * DM + 4 * lane + 256 * j); nb[j] = *(const u32x2*)(brbase + (size_t)gw * DM + 4 * lane + 256 * j); } }
    for (int row = gw; row < TG; row += NGW) {
        const int b = g * BG + row / SEQ; const float* sh = mod + (size_t)b * MODW + 3 * DM; const float* sc = sh + DM;
        float* xr = x1 + (size_t)row * DM;
        f32x4 v[4]; float s = 0.f;
#pragma unroll
        for (int j = 0; j < 4; ++j) { const u32x2 bw = nb[j];
            v[j] = nx[j] * ALPHA + (f32x4){bflo(bw.x), bfhi(bw.x), bflo(bw.y), bfhi(bw.y)}; s += (v[j].x + v[j].y) + (v[j].z + v[j].w); }
        if (row + NGW < TG) { const size_t nr = (size_t)(row + NGW) * DM;
#pragma unroll
            for (int j = 0; j < 4; ++j) { nx[j] = *(const f32x4*)(xbase + nr + 4 * lane + 256 * j); nb[j] = *(const u32x2*)(brbase + nr + 4 * lane + 256 * j); } }
        float mean = wave_sum(s, lane) * (1.f / DM); float s2 = 0.f;
#pragma unroll
        for (int j = 0; j < 4; ++j) { v[j] = v[j] - mean; s2 += (v[j].x * v[j].x + v[j].y * v[j].y) + (v[j].z * v[j].z + v[j].w * v[j].w); }
        float rstd = __builtin_amdgcn_rsqf(wave_sum(s2, lane) * (1.f / DM) + 1e-6f);
        s = 0.f;
#pragma unroll
        for (int j = 0; j < 4; ++j) { const int col = 4 * lane + 256 * j; const f32x4 ga = gaH[j], be = beH[j];
            v[j] = v[j] * rstd * ga + be; *(f32x4*)(xr + col) = v[j]; s += (v[j].x + v[j].y) + (v[j].z + v[j].w); }
        mean = wave_sum(s, lane) * (1.f / DM); s2 = 0.f;
#pragma unroll
        for (int j = 0; j < 4; ++j) { v[j] = v[j] - mean; s2 += (v[j].x * v[j].x + v[j].y * v[j].y) + (v[j].z * v[j].z + v[j].w * v[j].w); }
        rstd = __builtin_amdgcn_rsqf(wave_sum(s2, lane) * (1.f / DM) + 1e-6f);
#pragma unroll
        for (int j = 0; j < 4; ++j) { const int col = 4 * lane + 256 * j; const f32x4 a = *(const f32x4*)(sc + col), bb = *(const f32x4*)(sh + col);
            const f32x4 o = v[j] * rstd * (a + 1.f) + bb; u32x2 w; w.x = cvt_pk_bf16(o.x, o.y); w.y = cvt_pk_bf16(o.z, o.w);
            *(u32x2*)(h1 + (size_t)row * DM + col) = w; }
    }
}
__device__ __forceinline__ void phase_ln2(const Params& p, int g, int gw, int NGW, int lane) {
    const float* x1base = (const float*)(p.ws + OFF_X1); const bf16_t* brbase = (const bf16_t*)(p.ws + OFF_BR2);
    f32x4 gaH[4], beH[4];
#pragma unroll
    for (int j = 0; j < 4; ++j) { gaH[j] = *(const f32x4*)(p.ln2_g + 4 * lane + 256 * j); beH[j] = *(const f32x4*)(p.ln2_b + 4 * lane + 256 * j); }
    f32x4 nx[4]; u32x2 nb[4];
    if (gw < TG) {
#pragma unroll
        for (int j = 0; j < 4; ++j) { nx[j] = *(const f32x4*)(x1base + (size_t)gw * DM + 4 * lane + 256 * j); nb[j] = *(const u32x2*)(brbase + (size_t)gw * DM + 4 * lane + 256 * j); } }
    for (int row = gw; row < TG; row += NGW) {
        float* xr = p.out + ((size_t)g * TG + row) * DM;
        f32x4 v[4]; float s = 0.f;
#pragma unroll
        for (int j = 0; j < 4; ++j) { const u32x2 bw = nb[j];
            v[j] = nx[j] * ALPHA + (f32x4){bflo(bw.x), bfhi(bw.x), bflo(bw.y), bfhi(bw.y)}; s += (v[j].x + v[j].y) + (v[j].z + v[j].w); }
        if (row + NGW < TG) { const size_t nr = (size_t)(row + NGW) * DM;
#pragma unroll
            for (int j = 0; j < 4; ++j) { nx[j] = *(const f32x4*)(x1base + nr + 4 * lane + 256 * j); nb[j] = *(const u32x2*)(brbase + nr + 4 * lane + 256 * j); } }
        const float mean = wave_sum(s, lane) * (1.f / DM); float s2 = 0.f;
#pragma unroll
        for (int j = 0; j < 4; ++j) { v[j] = v[j] - mean; s2 += (v[j].x * v[j].x + v[j].y * v[j].y) + (v[j].z * v[j].z + v[j].w * v[j].w); }
        const float rstd = __builtin_amdgcn_rsqf(wave_sum(s2, lane) * (1.f / DM) + 1e-6f);
#pragma unroll
        for (int j = 0; j < 4; ++j) { const int col = 4 * lane + 256 * j;
            *(f32x4*)(xr + col) = v[j] * rstd * gaH[j] + beH[j]; }
    }
}

__device__ __forceinline__ void conv_fetch(const bf16_t* raw, int item, int tid, u32x4 (&rg)[3]) {
    constexpr int NFB = 80;
    const int ch = item / NFB, fb = item % NFB;
    const bool is_ctx = ch < (CGR / 128);
    const long row0 = (long)ch * 128;
#pragma unroll
    for (int i = 0; i < 3; ++i) {
        const int idx = tid + 512 * i;
        rg[i] = (u32x4){0u, 0u, 0u, 0u};
        if (idx < 134 * 8) { const int ir = idx >> 3, c8 = idx & 7; int tok; bool ok;
            if (is_ctx) { tok = ir - 2; const int gt = (ch & 1) * 128 + tok; ok = (ir < 131) && gt >= 0 && gt < 256; }
            else { const int sg = ir >= 67 ? 1 : 0, q = ir - 67 * sg; tok = 64 * sg + q - 2; ok = q >= 2 && q < 66; }
            if (ok) rg[i] = *(const u32x4*)(raw + (size_t)(row0 + tok) * NA + fb * 64 + c8 * 8); }
    }
}
__device__ __forceinline__ void phase_conv(const Params& p, LAS unsigned char* lds, int wg, int G, int tid) {
    const bf16_t* raw = (const bf16_t*)(p.ws + OFF_RAW);
    bf16_t* xT = (bf16_t*)(p.ws + OFF_XT); bf16_t* bm = (bf16_t*)(p.ws + OFF_BM); bf16_t* bT = (bf16_t*)(p.ws + OFF_BT);
    bf16_t* cm = (bf16_t*)(p.ws + OFF_CM); bf16_t* uu = (bf16_t*)(p.ws + OFF_U); float* dt = (float*)(p.ws + OFF_DT);
    constexpr int NCH = RG / 128, NFB = 80, NIT = NCH * NFB;
    const int f = tid & 63, tg = tid >> 6;
    for (int ch = wg; ch < NCH; ch += G) {
        const float bias = p.ssd_dt_bias[f];
        unsigned short rv[16];
#pragma unroll
        for (int k = 0; k < 16; ++k) rv[k] = raw[((size_t)ch * 128 + tg * 16 + k) * NA + 5120 + f];
#pragma unroll
        for (int k = 0; k < 16; ++k) { const size_t row = (size_t)ch * 128 + tg * 16 + k; const float v = bf2f(rv[k]) + bias;
            dt[row * 64 + f] = v > 20.f ? v : log1p_small(__expf(v)); }
    }
    u32x4 rg[3];
    int item = wg, buf = 0;
    if (item < NIT) conv_fetch(raw, item, tid, rg);
    for (; item < NIT; item += G) {
        LAS float* tile = (LAS float*)(lds + buf * 34816);
#pragma unroll
        for (int i = 0; i < 3; ++i) { const int idx = tid + 512 * i;
            if (idx < 134 * 8) { LAS float* d = tile + (idx >> 3) * 64 + (idx & 7) * 8; const u32x4 w = rg[i];
                *(LAS f32x4*)d = (f32x4){bflo(w.x), bfhi(w.x), bflo(w.y), bfhi(w.y)}; *(LAS f32x4*)(d + 4) = (f32x4){bflo(w.z), bfhi(w.z), bflo(w.w), bfhi(w.w)}; } }
        __syncthreads();
        if (item + G < NIT) conv_fetch(raw, item + G, tid, rg);
        const int ch = item / NFB, fb = item % NFB;
        const size_t row0 = (size_t)ch * 128;
        const int fp = tid & 31, tq = tid >> 5;
        const int feat = fb * 64 + 2 * fp;
        f32x2 w0, w1, w2, w3, bias;
        if (feat < 4096) { w0 = *(const f32x2*)(p.ssd_conv_w + feat); w1 = *(const f32x2*)(p.ssd_conv_w + 4096 + feat); w2 = *(const f32x2*)(p.ssd_conv_w + 8192 + feat); w3 = *(const f32x2*)(p.ssd_conv_w + 12288 + feat); bias = *(const f32x2*)(p.ssd_conv_b + feat); }
        else { const int lf = feat - 4096; w0 = *(const f32x2*)(p.lru_conv_w + lf); w1 = *(const f32x2*)(p.lru_conv_w + 1024 + lf); w2 = *(const f32x2*)(p.lru_conv_w + 2048 + lf); w3 = *(const f32x2*)(p.lru_conv_w + 3072 + lf); bias = *(const f32x2*)(p.lru_conv_b + lf); }
        const bool is_ctx = ch < (CGR / 128);
        const bool act = fb < 64;
        f32x2 o[8];
        const int ib0 = is_ctx ? tq * 8 : (tq >> 3) * 67 + (tq & 7) * 8;
        const LAS f32x2* tp = (const LAS f32x2*)tile + fp;
        f32x2 v0 = tp[(ib0 + 0) * 32], v1 = tp[(ib0 + 1) * 32], v2 = tp[(ib0 + 2) * 32];
#pragma unroll
        for (int k = 0; k < 8; ++k) {
            const f32x2 v3 = tp[(ib0 + k + 3) * 32];
            f32x2 a = bias + w0 * v0 + w1 * v1 + w2 * v2 + w3 * v3;
            if (act) { f32x2 d; d.x = 1.f + __expf(-a.x); d.y = 1.f + __expf(-a.y); f32x2 rc; rc.x = __builtin_amdgcn_rcpf(d.x); rc.y = __builtin_amdgcn_rcpf(d.y); a = a * rc; }
            o[k] = a;
            v0 = v1; v1 = v2; v2 = v3;
        }
        if (fb < 48) {
            bf16_t* dst = (fb < 32) ? xT + ((size_t)ch * 2048 + feat) * 128 + tq * 8 : bT + ((size_t)ch * 1024 + (feat - 2048)) * 128 + tq * 8;
            u32x4 a, b; a.x = cvt_pk_bf16(o[0].x, o[1].x); a.y = cvt_pk_bf16(o[2].x, o[3].x); a.z = cvt_pk_bf16(o[4].x, o[5].x); a.w = cvt_pk_bf16(o[6].x, o[7].x);
            b.x = cvt_pk_bf16(o[0].y, o[1].y); b.y = cvt_pk_bf16(o[2].y, o[3].y); b.z = cvt_pk_bf16(o[4].y, o[5].y); b.w = cvt_pk_bf16(o[6].y, o[7].y);
            *(u32x4*)dst = a; *(u32x4*)(dst + 128) = b;
        }
        if (fb >= 32 && !(is_ctx && fb >= 48 && fb < 64)) {
            bf16_t* dst = (fb < 48) ? bm + (feat - 2048) : (fb < 64) ? cm + (feat - 3072) : uu + (feat - 4096);
#pragma unroll
            for (int k = 0; k < 8; ++k) *(unsigned*)(dst + (row0 + tq * 8 + k) * 1024) = cvt_pk_bf16(o[k].x, o[k].y);
        }
        buf ^= 1;
    }
    __syncthreads();
}

__device__ __forceinline__ float wave_prefix(float v, int lane) {
#pragma unroll
    for (int o = 1; o < 64; o <<= 1) { const float t = lane_get(v, (lane - o) & 63); if (lane >= o) v += t; }
    return v;
}
__device__ __forceinline__ float wave_suffix(float v, int lane) {
#pragma unroll
    for (int o = 1; o < 64; o <<= 1) { const float t = lane_get(v, (lane + o) & 63); if (lane + o < 64) v += t; }
    return v;
}
__device__ __forceinline__ void tile_load(LAS unsigned char* dst, const bf16_t* g, int gstride, int wid, int lane) {
#pragma unroll
    for (int i = 0; i < 4; ++i) {
        const int instr = wid * 4 + i, row = 4 * instr + (lane >> 4), lc = (lane & 15) ^ (row & 15);
        __builtin_amdgcn_global_load_lds((const unsigned*)(g + (size_t)row * gstride + lc * 8), (LAS unsigned*)(dst + instr * 1024), 16, 0, 0);
    }
}
__device__ __forceinline__ bf16x8 t_ld8(const LAS unsigned char* t, unsigned rowoff, unsigned rx4, int col16) { return *(const LAS bf16x8*)(t + rowoff + (((unsigned)col16 << 4) ^ rx4)); }
__device__ __forceinline__ bf16x8 t_ld44(const LAS unsigned char* t, unsigned rowoff, unsigned rx4, int col16, int h) {
    const u32x2 lo = *(const LAS u32x2*)(t + rowoff + (((unsigned)col16 << 4) ^ rx4) + 8 * h), hi = *(const LAS u32x2*)(t + rowoff + (((unsigned)(col16 + 1) << 4) ^ rx4) + 8 * h);
    u32x4 w; w.x = lo.x; w.y = lo.y; w.z = hi.x; w.w = hi.y; return __builtin_bit_cast(bf16x8, w);
}
template <int DIR, int MODE = 0>
__device__ __forceinline__ void ssd_item(const Params& p, int item, LAS unsigned char* lds, int wid, int lane) {
    const int bl = item >> 3, grp = item & 7;
    const int head = grp * 4 + (wid >> 1), pb = wid & 1;
    const int r = lane & 31, h = lane >> 5;
    const unsigned rowoff = (unsigned)r * 256u, rx4 = (unsigned)(r & 15) << 4;
    LAS unsigned char* TA = lds; LAS unsigned char* TB = lds + 32768; LAS unsigned char* TC = lds + 65536;
    LAS unsigned char* CBL = lds + 131072;
    LAS float* cumL = (LAS float*)(lds + 98304 + wid * 4096); LAS float* dtL = cumL + 128; LAS float* sclL = cumL + 256; LAS float* wL = cumL + 384;
    const bf16_t* xT = (const bf16_t*)(p.ws + OFF_XT); const bf16_t* bm = (const bf16_t*)(p.ws + OFF_BM); const bf16_t* bT = (const bf16_t*)(p.ws + OFF_BT);
    const bf16_t* cm = (const bf16_t*)(p.ws + OFF_CM); const float* dt = (const float*)(p.ws + OFF_DT);
    bf16_t* yout = (bf16_t*)(p.ws + (DIR ? OFF_Y2 : OFF_Y1));
    const float a_neg = -__expf(p.ssd_a_log[DIR * 32 + head]);
    const float Dh = p.ssd_d[head];
    f32x16 H[4];
#pragma unroll
    for (int nb = 0; nb < 4; ++nb)
#pragma unroll
        for (int e = 0; e < 16; ++e) H[nb][e] = 0.f;
    asm volatile("" ::: "memory"); __builtin_amdgcn_s_barrier(); asm volatile("" ::: "memory");
    { const int ch0 = bl * 2 + (DIR ? 1 : 0); tile_load(TC, bT + ((size_t)ch0 * 1024 + grp * 128) * 128, 128, wid, lane); }
    float nd0, nd1;
    { const size_t r0 = (size_t)(bl * 2 + (DIR ? 1 : 0)) * 128; nd0 = dt[(r0 + lane) * 64 + DIR * 32 + head]; nd1 = dt[(r0 + 64 + lane) * 64 + DIR * 32 + head]; }
#pragma unroll 1
    for (int s = 0; s < 18; ++s) {
        const bool is_ctx = s < 2;
        const int c = is_ctx ? (DIR ? 1 - s : s) : (DIR ? 17 - s : s - 2);
        const int chunk = is_ctx ? bl * 2 + c : (CGR / 128) + bl * 16 + c;
        const size_t row0 = (size_t)chunk * 128;
        const float d0 = nd0, d1 = nd1;
        const bf16_t* XT = xT + ((size_t)chunk * 2048 + head * 64 + pb * 32 + r) * 128;
        asm volatile("s_waitcnt vmcnt(0)" ::: "memory"); __builtin_amdgcn_s_barrier(); asm volatile("" ::: "memory");
        if (s + 1 < 18) { const int s1 = s + 1; const bool cx1 = s1 < 2; const int c1 = cx1 ? (DIR ? 1 - s1 : s1) : (DIR ? 17 - s1 : s1 - 2);
            const size_t rn = (size_t)(cx1 ? bl * 2 + c1 : (CGR / 128) + bl * 16 + c1) * 128;
            nd0 = dt[(rn + lane) * 64 + DIR * 32 + head]; nd1 = dt[(rn + 64 + lane) * 64 + DIR * 32 + head]; }
        float c0, c1, ctot;
        if (DIR == 0) { const float p0 = wave_prefix(d0 * a_neg, lane); const float tot0 = __int_as_float(__builtin_amdgcn_readlane(__float_as_int(p0), 63)); const float p1 = wave_prefix(d1 * a_neg, lane) + tot0; c0 = p0; c1 = p1; ctot = __int_as_float(__builtin_amdgcn_readlane(__float_as_int(p1), 63)); }
        else { const float s1 = wave_suffix(d1 * a_neg, lane); const float tot1 = __int_as_float(__builtin_amdgcn_readlane(__float_as_int(s1), 0)); const float s0 = wave_suffix(d0 * a_neg, lane) + tot1; c0 = s0; c1 = s1; ctot = __int_as_float(__builtin_amdgcn_readlane(__float_as_int(s0), 0)); }
        cumL[lane] = c0; cumL[lane + 64] = c1; dtL[lane] = d0; dtL[lane + 64] = d1;
        sclL[lane] = d0 * __expf(ctot - c0); sclL[lane + 64] = d1 * __expf(ctot - c1);
        LDS_FENCE();
        float mref[4];
        if (DIR == 0) { mref[0] = 0.f; mref[1] = cumL[31]; mref[2] = cumL[63]; mref[3] = cumL[95]; }
        else { mref[0] = cumL[32]; mref[1] = cumL[64]; mref[2] = cumL[96]; mref[3] = 0.f; }
#pragma unroll
        for (int ib = 0; ib < 4; ++ib) mref[ib] = __int_as_float(__builtin_amdgcn_readfirstlane(__float_as_int(mref[ib])));
        if (!is_ctx) {
#pragma unroll
            for (int ib = 0; ib < 4; ++ib) { wL[ib * 128 + lane] = d0 * __expf(mref[ib] - c0); wL[ib * 128 + 64 + lane] = d1 * __expf(mref[ib] - c1); }
            LDS_FENCE();
#pragma unroll 1
            for (int bidx = wid; bidx < 10; bidx += 8) {
                int bi2 = bidx >= 6 ? 3 : bidx >= 3 ? 2 : bidx >= 1 ? 1 : 0; int bj2 = bidx - bi2 * (bi2 + 1) / 2;
                const int ibk = DIR ? 3 - bi2 : bi2, jbk = DIR ? 3 - bj2 : bj2;
                const unsigned io2 = rowoff + (unsigned)ibk * 8192u, jo2 = rowoff + (unsigned)jbk * 8192u;
                f32x16 S;
#pragma unroll
                for (int e = 0; e < 16; ++e) S[e] = 0.f;
#pragma unroll
                for (int s8 = 0; s8 < 8; ++s8) S = mfma32(t_ld8(TB, jo2, rx4, 2 * s8 + h), t_ld8(TA, io2, rx4, 2 * s8 + h), S);
                asm volatile("s_nop 15\n\ts_nop 3" : "+v"(S));
                LAS u32x4* dstp = (LAS u32x4*)(CBL + bidx * 2048 + lane * 32);
                u32x4 w0, w1; w0.x = cvt_pk_bf16(S[0], S[1]); w0.y = cvt_pk_bf16(S[2], S[3]); w0.z = cvt_pk_bf16(S[4], S[5]); w0.w = cvt_pk_bf16(S[6], S[7]);
                w1.x = cvt_pk_bf16(S[8], S[9]); w1.y = cvt_pk_bf16(S[10], S[11]); w1.z = cvt_pk_bf16(S[12], S[13]); w1.w = cvt_pk_bf16(S[14], S[15]);
                dstp[0] = w0; dstp[1] = w1;
            }
            LDS_FENCE();
            asm volatile("" ::: "memory"); __builtin_amdgcn_s_barrier(); asm volatile("" ::: "memory");
        }
        if (!is_ctx && MODE != 1) {
            bf16_t* Y = yout + ((size_t)(bl * 16 + c) * 128) * 2048 + head * 64 + pb * 32;
#pragma unroll 1
            for (int ib = 0; ib < 4; ++ib) {
                const unsigned ioff = rowoff + (unsigned)ib * 8192u;
                f32x16 Ya;
#pragma unroll
                for (int e = 0; e < 16; ++e) Ya[e] = 0.f;
#pragma unroll
                for (int nb = 0; nb < 4; ++nb)
#pragma unroll
                    for (int sp = 0; sp < 2; ++sp) Ya = mfma32(pack_acc(H[nb], sp), t_ld44(TA, ioff, rx4, 4 * nb + 2 * sp, h), Ya);
                const float ci = cumL[32 * ib + r];
                const float mi = (ib == 0) ? mref[0] : (ib == 1) ? mref[1] : (ib == 2) ? mref[2] : mref[3];
                { const float em = __expf(mi);
#pragma unroll
                  for (int e = 0; e < 16; ++e) Ya[e] *= em; }
#pragma unroll 3
                for (int jb = (DIR ? ib + 1 : 0); jb < (DIR ? 4 : ib); ++jb) {
                    f32x16 S;
                    { const int bi2 = DIR ? 3 - ib : ib, bj2 = DIR ? 3 - jb : jb; const LAS u32x4* srcp = (const LAS u32x4*)(CBL + (bi2 * (bi2 + 1) / 2 + bj2) * 2048 + lane * 32);
                      const u32x4 w0 = srcp[0], w1 = srcp[1];
                      S[0] = bflo(w0.x); S[1] = bfhi(w0.x); S[2] = bflo(w0.y); S[3] = bfhi(w0.y); S[4] = bflo(w0.z); S[5] = bfhi(w0.z); S[6] = bflo(w0.w); S[7] = bfhi(w0.w);
                      S[8] = bflo(w1.x); S[9] = bfhi(w1.x); S[10] = bflo(w1.y); S[11] = bfhi(w1.y); S[12] = bflo(w1.z); S[13] = bfhi(w1.z); S[14] = bflo(w1.w); S[15] = bfhi(w1.w); }
#pragma unroll
                    for (int q = 0; q < 4; ++q) { const f32x4 w4 = *(const LAS f32x4*)(wL + ib * 128 + 32 * jb + 8 * q + 4 * h);
#pragma unroll
                        for (int k = 0; k < 4; ++k) S[4 * q + k] *= w4[k]; }
                    Ya = mfma32(ld44(XT + 32 * jb + 4 * h), pack_acc(S, 0), Ya); Ya = mfma32(ld44(XT + 32 * jb + 16 + 4 * h), pack_acc(S, 1), Ya);
                }
                { const float ec = __expf(ci - mi);
#pragma unroll
                  for (int e = 0; e < 16; ++e) Ya[e] *= ec; }
                {
                    const int i = 32 * ib + r; const int jb = ib;
                    f32x16 S;
                    { const int bi2 = DIR ? 3 - ib : ib, bj2 = DIR ? 3 - jb : jb; const LAS u32x4* srcp = (const LAS u32x4*)(CBL + (bi2 * (bi2 + 1) / 2 + bj2) * 2048 + lane * 32);
                      const u32x4 w0 = srcp[0], w1 = srcp[1];
                      S[0] = bflo(w0.x); S[1] = bfhi(w0.x); S[2] = bflo(w0.y); S[3] = bfhi(w0.y); S[4] = bflo(w0.z); S[5] = bfhi(w0.z); S[6] = bflo(w0.w); S[7] = bfhi(w0.w);
                      S[8] = bflo(w1.x); S[9] = bfhi(w1.x); S[10] = bflo(w1.y); S[11] = bfhi(w1.y); S[12] = bflo(w1.z); S[13] = bfhi(w1.z); S[14] = bflo(w1.w); S[15] = bfhi(w1.w); }
#pragma unroll
                    for (int q = 0; q < 4; ++q) {
                        const int j0 = 32 * jb + 8 * q + 4 * h;
                        const f32x4 cj = *(const LAS f32x4*)(cumL + j0), dj = *(const LAS f32x4*)(dtL + j0);
#pragma unroll
                        for (int k = 0; k < 4; ++k) {
                            const int j = j0 + k; const bool valid = DIR ? (j >= i) : (j <= i);
                            float v = S[4 * q + k] * __expf(ci - cj[k]) * dj[k];
                            v = valid ? v : 0.f;
                            if (DIR == 0 && j == i) v += Dh;
                            S[4 * q + k] = v;
                        }
                    }
                    Ya = mfma32(ld44(XT + 32 * jb + 4 * h), pack_acc(S, 0), Ya); Ya = mfma32(ld44(XT + 32 * jb + 16 + 4 * h), pack_acc(S, 1), Ya);
                }
                asm volatile("s_nop 15\n\ts_nop 3" : "+v"(Ya));
                bf16_t* yr = Y + (size_t)(32 * ib + r) * 2048 + 4 * h;
#pragma unroll
                for (int q = 0; q < 4; ++q) { u32x2 w; w.x = cvt_pk_bf16(Ya[4 * q], Ya[4 * q + 1]); w.y = cvt_pk_bf16(Ya[4 * q + 2], Ya[4 * q + 3]); if (MODE != 3 || w.x == 0x12345678u) *(u32x2*)(yr + 8 * q) = w; }
            }
        }
        const float dec = __expf(ctot);
#pragma unroll
        for (int nb = 0; nb < 4; ++nb)
#pragma unroll
            for (int e = 0; e < 16; ++e) H[nb][e] *= dec;
#pragma unroll
        for (int s8 = 0; s8 < ((MODE == 2 || MODE == 3) ? 0 : 8); ++s8) {
            const u32x4 xr = *(const u32x4*)(XT + 16 * s8 + 8 * h);
            const f32x4 sa = *(const LAS f32x4*)(sclL + 16 * s8 + 8 * h), sb = *(const LAS f32x4*)(sclL + 16 * s8 + 8 * h + 4);
            u32x4 w; w.x = cvt_pk_bf16(bflo(xr.x) * sa.x, bfhi(xr.x) * sa.y); w.y = cvt_pk_bf16(bflo(xr.y) * sa.z, bfhi(xr.y) * sa.w);
            w.z = cvt_pk_bf16(bflo(xr.z) * sb.x, bfhi(xr.z) * sb.y); w.w = cvt_pk_bf16(bflo(xr.w) * sb.z, bfhi(xr.w) * sb.w);
            const bf16x8 Xs = __builtin_bit_cast(bf16x8, w);
#pragma unroll
            for (int nb = 0; nb < 4; ++nb) H[nb] = mfma32(t_ld8(TC, rowoff + (unsigned)nb * 8192u, rx4, 2 * s8 + h), Xs, H[nb]);
        }
        asm volatile("" ::: "memory"); __builtin_amdgcn_s_barrier(); asm volatile("" ::: "memory");
        if (s + 1 < 18) {
            const int s1 = s + 1; const bool ctx1 = s1 < 2; const int c1n = ctx1 ? (DIR ? 1 - s1 : s1) : (DIR ? 17 - s1 : s1 - 2);
            const int chn = ctx1 ? bl * 2 + c1n : (CGR / 128) + bl * 16 + c1n;
            tile_load(TC, bT + ((size_t)chn * 1024 + grp * 128) * 128, 128, wid, lane);
            if (!ctx1) { const size_t rown = (size_t)chn * 128; tile_load(TA, cm + rown * 1024 + grp * 128, 1024, wid, lane); tile_load(TB, bm + rown * 1024 + grp * 128, 1024, wid, lane); }
        }
    }
    asm volatile("s_waitcnt vmcnt(0)" ::: "memory");
}

template <int DIR>
__device__ __forceinline__ void lru_item(const Params& p, int item, int lane) {
    const int db = item & 3, blk = (item >> 2) & 7, bl = item >> 5;
    const int r = lane & 31, h = lane >> 5;
    const int dl = db * 32 + r, d = blk * 128 + dl;
    const bf16_t* WGt = (const bf16_t*)(p.ws + OFF_WG);
    const bf16_t* wa = WGt + ((size_t)((DIR * 8 + blk) * 2 + 0) * 128 + dl) * 128 + 8 * h;
    const bf16_t* wi = WGt + ((size_t)((DIR * 8 + blk) * 2 + 1) * 128 + dl) * 128 + 8 * h;
    bf16x8 Wa[8], Wi[8];
#pragma unroll
    for (int s = 0; s < 8; ++s) { Wa[s] = ld8(wa + 16 * s); Wi[s] = ld8(wi + 16 * s); }
    bf16x8 I0, I1;
#pragma unroll
    for (int e = 0; e < 8; ++e) { I0[e] = (16 * (2 * db) + 8 * h + e == dl) ? (short)0x3F80 : (short)0; I1[e] = (16 * (2 * db + 1) + 8 * h + e == dl) ? (short)0x3F80 : (short)0; }
    const float ba = p.lru_ba[DIR * 1024 + d], bi = p.lru_bi[DIR * 1024 + d];
    const float c8 = -8.f * log1p_small(__expf(-p.lru_lambda[DIR * 1024 + d]));
    const bf16_t* uu = (const bf16_t*)(p.ws + OFF_U);
    bf16_t* yl = (bf16_t*)(p.ws + (DIR ? OFF_YLB : OFF_YLF));
    float hst = 0.f;
    auto tile_row0 = [&](int t) -> size_t { const bool cx = t < 8; const int tl = cx ? (DIR ? 7 - t : t) : (DIR ? 71 - t : t - 8);
        return cx ? (size_t)bl * 256 + tl * 32 : (size_t)CGR + (size_t)bl * 2048 + tl * 32; };
    bf16x8 uf[8], ui0, ui1;
    { const bf16_t* up = uu + (tile_row0(0) + r) * 1024 + blk * 128 + 8 * h;
#pragma unroll
      for (int s = 0; s < 8; ++s) uf[s] = ld8(up + 16 * s);
      ui0 = ld8(up + 32 * db); ui1 = ld8(up + 32 * db + 16); }
#pragma unroll 1
    for (int t = 0; t < 72; ++t) {
        const bool is_ctx = t < 8;
        const int tile = is_ctx ? (DIR ? 7 - t : t) : (DIR ? 71 - t : t - 8);
        f32x16 Aa, Ai, Au;
#pragma unroll
        for (int e = 0; e < 16; ++e) { Aa[e] = 0.f; Ai[e] = 0.f; Au[e] = 0.f; }
#pragma unroll
        for (int s = 0; s < 8; ++s) { Aa = mfma32(uf[s], Wa[s], Aa); Ai = mfma32(uf[s], Wi[s], Ai); }
        Au = mfma32(ui0, I0, Au); Au = mfma32(ui1, I1, Au);
        { const int tn = t + 1 < 72 ? t + 1 : 71; const bf16_t* up = uu + (tile_row0(tn) + r) * 1024 + blk * 128 + 8 * h;
#pragma unroll
          for (int s = 0; s < 8; ++s) uf[s] = ld8(up + 16 * s);
          ui0 = ld8(up + 32 * db); ui1 = ld8(up + 32 * db + 16); }
        float av[16], bv[16];
#pragma unroll
        for (int e = 0; e < 16; e += 2) {
            const f32x2 xa = (f32x2){Aa[e], Aa[e + 1]} + ba, xi = (f32x2){Ai[e], Ai[e + 1]} + bi, uv = (f32x2){Au[e], Au[e + 1]};
            const f32x2 ta = xa * -1.4426950408889634f, ti = xi * -1.4426950408889634f;
            f32x2 da, di; da.x = __builtin_amdgcn_exp2f(ta.x); da.y = __builtin_amdgcn_exp2f(ta.y); di.x = __builtin_amdgcn_exp2f(ti.x); di.y = __builtin_amdgcn_exp2f(ti.y);
            da = da + 1.f; di = di + 1.f;
            f32x2 ra, ri; ra.x = __builtin_amdgcn_rcpf(da.x); ra.y = __builtin_amdgcn_rcpf(da.y); ri.x = __builtin_amdgcn_rcpf(di.x); ri.y = __builtin_amdgcn_rcpf(di.y);
            const f32x2 la = ra * (c8 * 1.4426950408889634f);
            f32x2 a; a.x = __builtin_amdgcn_exp2f(la.x); a.y = __builtin_amdgcn_exp2f(la.y);
            f32x2 om = 1.f - a * a; om.x = fmaxf(om.x, 0.f); om.y = fmaxf(om.y, 0.f);
            f32x2 sq; sq.x = __builtin_amdgcn_sqrtf(om.x); sq.y = __builtin_amdgcn_sqrtf(om.y);
            const f32x2 b = sq * (ri * uv);
            const int k0 = DIR ? 15 - e : e, k1 = DIR ? 14 - e : e + 1;
            av[k0] = a.x; bv[k0] = b.x; av[k1] = a.y; bv[k1] = b.y;
        }
        const int hh = DIR ? 1 - h : h;
        float Ag[4], Bg[4];
#pragma unroll
        for (int q = 0; q < 4; q += 2) {
            f32x2 A = (f32x2){av[4 * q], av[4 * q + 4]}, B = (f32x2){bv[4 * q], bv[4 * q + 4]};
#pragma unroll
            for (int k = 1; k < 4; ++k) { const f32x2 ak = (f32x2){av[4 * q + k], av[4 * q + 4 + k]}, bk = (f32x2){bv[4 * q + k], bv[4 * q + 4 + k]};
                A = A * ak; B = B * ak + bk; av[4 * q + k] = A.x; av[4 * q + 4 + k] = A.y; bv[4 * q + k] = B.x; bv[4 * q + 4 + k] = B.y; }
            Ag[q] = A.x; Ag[q + 1] = A.y; Bg[q] = B.x; Bg[q + 1] = B.y;
        }
        float Ap[4], Bp[4];
#pragma unroll
        for (int q = 0; q < 4; ++q) { Ap[q] = lane_get(Ag[q], lane ^ 32); Bp[q] = lane_get(Bg[q], lane ^ 32); }
        float st = hst, hs[4];
#pragma unroll
        for (int Gi = 0; Gi < 8; ++Gi) {
            const int q = Gi >> 1; const bool own = (hh == (Gi & 1));
            const float A = own ? Ag[q] : Ap[q], B = own ? Bg[q] : Bp[q];
            if (own) hs[q] = st;
            st = A * st + B;
        }
        hst = st;
        if (!is_ctx) {
            bf16_t* yr = yl + ((size_t)bl * 2048 + tile * 32) * 1024 + d;
#pragma unroll
            for (int e = 0; e < 16; ++e) { const int k = DIR ? 15 - e : e; const float hv = av[k] * hs[k >> 2] + bv[k];
                const int tok = (e & 3) + 8 * (e >> 2) + 4 * h; yr[(size_t)tok * 1024] = f2bf(hv); }
        }
    }
}

struct EpiRaw {
    static constexpr bool PERM = true;
    bf16_t* O; int ldc;
    __device__ __forceinline__ void operator()(f32x4 (&acc)[2][2][4][2], const Unit& u, int wr, int wc, int fr, int fq) const {
        const int row0 = u.pm * 256 + wr * 64 + fr, col0 = u.pn * 256 + wc * 32 + 8 * fq;
#pragma unroll
        for (int ai = 0; ai < 2; ++ai)
#pragma unroll
            for (int m = 0; m < 4; ++m) { bf16_t* rowp = O + (size_t)(row0 + ai * 128 + m * 16) * ldc + col0;
#pragma unroll
                for (int bj = 0; bj < 2; ++bj) { if (u.pn * 256 + bj * 128 + wc * 32 >= 5184) continue;
                    const f32x4 v0 = acc[ai][bj][m][0], v1 = acc[ai][bj][m][1];
                    u32x4 w; w.x = cvt_pk_bf16(v0[0], v0[1]); w.y = cvt_pk_bf16(v0[2], v0[3]); w.z = cvt_pk_bf16(v1[0], v1[1]); w.w = cvt_pk_bf16(v1[2], v1[3]);
                    *(u32x4*)(rowp + bj * 128) = w; } }
    }
};
__device__ __forceinline__ float gelu_tanh(float x) { const float y = 0.7978845608028654f * (x + 0.044715f * x * x * x); const float t = 1.f - 2.f * __builtin_amdgcn_rcpf(1.f + __expf(2.f * y)); return 0.5f * x * (1.f + t); }
struct EpiG1b {
    static constexpr bool PERM = true;
    bf16_t* y1; const bf16_t* y2; bf16_t* ylf; const bf16_t* ylb; bf16_t* gates; const float* b_gate; LAS float* xl;
    __device__ __forceinline__ void operator()(f32x4 (&acc)[2][2][4][2], const Unit& u, int wr, int wc, int fr, int fq) const {
        const int row0 = u.pm * 256 + wr * 64 + fr, c8 = wc * 32 + 8 * fq;
        if (u.pn < 8) {
            unsigned xoff = (unsigned)(wr * 64 + fr) * 16u; asm volatile("" : "+v"(xoff));
            LAS float* xb = (LAS float*)((LAS unsigned char*)xl + xoff);
            float ssq[2][4];
#pragma unroll
            for (int ai = 0; ai < 2; ++ai) {
                u32x4 ya[4][2], yb[4][2];
#pragma unroll
                for (int m = 0; m < 4; ++m)
#pragma unroll
                    for (int bj = 0; bj < 2; ++bj) { const size_t idx = (size_t)(row0 + ai * 128 + m * 16) * 2048 + u.pn * 256 + bj * 128 + c8;
                        ya[m][bj] = *(const u32x4*)(y1 + idx); yb[m][bj] = *(const u32x4*)(y2 + idx); }
#pragma unroll
                for (int m = 0; m < 4; ++m) { ssq[ai][m] = 0.f;
#pragma unroll
                    for (int bj = 0; bj < 2; ++bj) { const u32x4 a = ya[m][bj], b = yb[m][bj];
                        float yv[8] = {bflo(a.x) + bflo(b.x), bfhi(a.x) + bfhi(b.x), bflo(a.y) + bflo(b.y), bfhi(a.y) + bfhi(b.y), bflo(a.z) + bflo(b.z), bfhi(a.z) + bfhi(b.z), bflo(a.w) + bflo(b.w), bfhi(a.w) + bfhi(b.w)};
#pragma unroll
                        for (int n = 0; n < 2; ++n)
#pragma unroll
                            for (int j = 0; j < 4; ++j) { const float z = acc[ai][bj][m][n][j]; const float gv = yv[4 * n + j] * siluf_(z); acc[ai][bj][m][n][j] = gv; ssq[ai][m] += gv * gv; } }
                    ssq[ai][m] += lane_get(ssq[ai][m], (fr | (fq << 4)) ^ 16); ssq[ai][m] += lane_get(ssq[ai][m], (fr | (fq << 4)) ^ 32);
                    if (fq == 0) xb[(ai * 128 + m * 16) * 4 + wc] = ssq[ai][m]; }
            }
            LDS_FENCE(); __builtin_amdgcn_s_barrier(); asm volatile("" ::: "memory");
#pragma unroll
            for (int ai = 0; ai < 2; ++ai)
#pragma unroll
                for (int m = 0; m < 4; ++m) { const f32x4 s4 = *(const LAS f32x4*)(xb + (ai * 128 + m * 16) * 4);
                    const float rstd = __builtin_amdgcn_rsqf(((s4.x + s4.y) + (s4.z + s4.w)) * (1.f / 256.f) + 1e-5f);
#pragma unroll
                    for (int bj = 0; bj < 2; ++bj) { const size_t idx = (size_t)(row0 + ai * 128 + m * 16) * 2048 + u.pn * 256 + bj * 128 + c8;
                        const f32x4 v0 = acc[ai][bj][m][0] * rstd, v1 = acc[ai][bj][m][1] * rstd;
                        u32x4 w; w.x = cvt_pk_bf16(v0[0], v0[1]); w.y = cvt_pk_bf16(v0[2], v0[3]); w.z = cvt_pk_bf16(v1[0], v1[1]); w.w = cvt_pk_bf16(v1[2], v1[3]);
                        *(u32x4*)(y1 + idx) = w; } }
        } else if (u.pn < 12) {
#pragma unroll
            for (int ai = 0; ai < 2; ++ai) {
                u32x4 ya[4][2], yb[4][2];
#pragma unroll
                for (int m = 0; m < 4; ++m)
#pragma unroll
                    for (int bj = 0; bj < 2; ++bj) { const size_t idx = (size_t)(row0 + ai * 128 + m * 16) * 1024 + (u.pn - 8) * 256 + bj * 128 + c8;
                        ya[m][bj] = *(const u32x4*)(ylf + idx); yb[m][bj] = *(const u32x4*)(ylb + idx); }
#pragma unroll
                for (int m = 0; m < 4; ++m)
#pragma unroll
                    for (int bj = 0; bj < 2; ++bj) { const size_t idx = (size_t)(row0 + ai * 128 + m * 16) * 1024 + (u.pn - 8) * 256 + bj * 128 + c8;
                        const u32x4 a = ya[m][bj], b = yb[m][bj];
                        float yv[8] = {bflo(a.x) + bflo(b.x), bfhi(a.x) + bfhi(b.x), bflo(a.y) + bflo(b.y), bfhi(a.y) + bfhi(b.y), bflo(a.z) + bflo(b.z), bfhi(a.z) + bfhi(b.z), bflo(a.w) + bflo(b.w), bfhi(a.w) + bfhi(b.w)};
                        float o[8];
#pragma unroll
                        for (int n = 0; n < 2; ++n)
#pragma unroll
                            for (int j = 0; j < 4; ++j) o[4 * n + j] = yv[4 * n + j] * gelu_tanh(acc[ai][bj][m][n][j]);
                        u32x4 w; w.x = cvt_pk_bf16(o[0], o[1]); w.y = cvt_pk_bf16(o[2], o[3]); w.z = cvt_pk_bf16(o[4], o[5]); w.w = cvt_pk_bf16(o[6], o[7]);
                        *(u32x4*)(ylf + idx) = w; }
            }
        } else {
#pragma unroll
            for (int bj = 0; bj < 2; ++bj) { const int col = (u.pn - 12) * 256 + bj * 128 + c8;
                const f32x4 b0 = *(const f32x4*)(b_gate + col), b1 = *(const f32x4*)(b_gate + col + 4);
#pragma unroll
                for (int ai = 0; ai < 2; ++ai)
#pragma unroll
                    for (int m = 0; m < 4; ++m) { const f32x4 v0 = acc[ai][bj][m][0] + b0, v1 = acc[ai][bj][m][1] + b1;
                        u32x4 w; w.x = cvt_pk_bf16(sigmoidf_(v0[0]), sigmoidf_(v0[1])); w.y = cvt_pk_bf16(sigmoidf_(v0[2]), sigmoidf_(v0[3]));
                        w.z = cvt_pk_bf16(sigmoidf_(v1[0]), sigmoidf_(v1[1])); w.w = cvt_pk_bf16(sigmoidf_(v1[2]), sigmoidf_(v1[3]));
                        *(u32x4*)(gates + (size_t)(row0 + ai * 128 + m * 16) * 2048 + col) = w; } }
        }
    }
};
struct EpiBrS {
    static constexpr bool PERM = false;
    const bf16_t* gates; bf16_t* tmp;
    __device__ __forceinline__ void operator()(f32x4 (&acc)[2][2][4][2], const Unit& u, int wr, int wc, int fr, int fq) const {
        const int row0 = u.pm * 256 + wr * 64 + fr, col0 = u.pn * 256 + wc * 32 + 4 * fq;
#pragma unroll
        for (int ai = 0; ai < 2; ++ai) {
            u32x2 gw[4][2][2];
#pragma unroll
            for (int m = 0; m < 4; ++m)
#pragma unroll
                for (int bj = 0; bj < 2; ++bj)
#pragma unroll
                    for (int n = 0; n < 2; ++n) gw[m][bj][n] = *(const u32x2*)(gates + (size_t)(row0 + ai * 128 + m * 16) * 2048 + col0 + bj * 128 + n * 16);
#pragma unroll
            for (int m = 0; m < 4; ++m) { const size_t row = row0 + ai * 128 + m * 16;
#pragma unroll
                for (int bj = 0; bj < 2; ++bj)
#pragma unroll
                    for (int n = 0; n < 2; ++n) { const int col = col0 + bj * 128 + n * 16; const u32x2 g2 = gw[m][bj][n];
                        const f32x4 gv = (f32x4){bflo(g2.x), bfhi(g2.x), bflo(g2.y), bfhi(g2.y)};
                        const f32x4 o = gv * acc[ai][bj][m][n]; u32x2 w; w.x = cvt_pk_bf16(o[0], o[1]); w.y = cvt_pk_bf16(o[2], o[3]); *(u32x2*)(tmp + row * 1024 + col) = w; } }
        }
    }
};
struct EpiBrL {
    static constexpr bool PERM = false;
    const bf16_t* gates; const bf16_t* tmp; bf16_t* merged;
    __device__ __forceinline__ void operator()(f32x4 (&acc)[2][2][4][2], const Unit& u, int wr, int wc, int fr, int fq) const {
        const int row0 = u.pm * 256 + wr * 64 + fr, col0 = u.pn * 256 + wc * 32 + 4 * fq;
#pragma unroll
        for (int ai = 0; ai < 2; ++ai) {
            u32x2 gw[4][2][2], tw[4][2][2];
#pragma unroll
            for (int m = 0; m < 4; ++m)
#pragma unroll
                for (int bj = 0; bj < 2; ++bj)
#pragma unroll
                    for (int n = 0; n < 2; ++n) { const size_t row = row0 + ai * 128 + m * 16; const int col = col0 + bj * 128 + n * 16;
                        gw[m][bj][n] = *(const u32x2*)(gates + row * 2048 + 1024 + col); tw[m][bj][n] = *(const u32x2*)(tmp + row * 1024 + col); }
#pragma unroll
            for (int m = 0; m < 4; ++m) { const size_t row = row0 + ai * 128 + m * 16;
#pragma unroll
                for (int bj = 0; bj < 2; ++bj)
#pragma unroll
                    for (int n = 0; n < 2; ++n) { const int col = col0 + bj * 128 + n * 16; const u32x2 g2 = gw[m][bj][n], t2 = tw[m][bj][n];
                        const f32x4 gv = (f32x4){bflo(g2.x), bfhi(g2.x), bflo(g2.y), bfhi(g2.y)};
                        const f32x4 o = (f32x4){bflo(t2.x), bfhi(t2.x), bflo(t2.y), bfhi(t2.y)} + gv * acc[ai][bj][m][n];
                        u32x2 w; w.x = cvt_pk_bf16(o[0], o[1]); w.y = cvt_pk_bf16(o[2], o[3]); *(u32x2*)(merged + row * 1024 + col) = w; } }
        }
    }
};
struct EpiRes {
    static constexpr bool PERM = false;
    const float* gate; const float* bias; bf16_t* O; int bbase;
    __device__ __forceinline__ void operator()(f32x4 (&acc)[2][2][4][2], const Unit& u, int wr, int wc, int fr, int fq) const {
        const int row0 = u.pm * 256 + wr * 64 + fr, col0 = u.pn * 256 + wc * 32 + 4 * fq;
        const float* gr = gate + (size_t)(bbase + (u.pm * 256) / SEQ) * MODW;
#pragma unroll
        for (int bj = 0; bj < 2; ++bj)
#pragma unroll
            for (int n = 0; n < 2; ++n) { const int col = col0 + bj * 128 + n * 16; const f32x4 gv = *(const f32x4*)(gr + col);
                f32x4 bv = (f32x4){0.f, 0.f, 0.f, 0.f}; if (bias) bv = *(const f32x4*)(bias + col);
#pragma unroll
                for (int ai = 0; ai < 2; ++ai)
#pragma unroll
                    for (int m = 0; m < 4; ++m) { const size_t row = row0 + ai * 128 + m * 16;
                        const f32x4 o = gv * (acc[ai][bj][m][n] + bv); u32x2 w; w.x = cvt_pk_bf16(o[0], o[1]); w.y = cvt_pk_bf16(o[2], o[3]);
                        *(u32x2*)(O + row * 1024 + col) = w; } }
    }
};
struct EpiMlp1 {
    static constexpr bool PERM = true;
    bf16_t* O; const float* bias;
    __device__ __forceinline__ void operator()(f32x4 (&acc)[2][2][4][2], const Unit& u, int wr, int wc, int fr, int fq) const {
        const int row0 = u.pm * 256 + wr * 64 + fr, col0 = u.pn * 256 + wc * 32 + 8 * fq;
#pragma unroll
        for (int bj = 0; bj < 2; ++bj) { const f32x4 b0 = *(const f32x4*)(bias + col0 + bj * 128), b1 = *(const f32x4*)(bias + col0 + bj * 128 + 4);
#pragma unroll
            for (int ai = 0; ai < 2; ++ai)
#pragma unroll
                for (int m = 0; m < 4; ++m) { f32x4 v0 = acc[ai][bj][m][0] + b0, v1 = acc[ai][bj][m][1] + b1;
#pragma unroll
                    for (int j = 0; j < 4; ++j) { v0[j] = fmaxf(v0[j], 0.f); v0[j] *= v0[j]; v1[j] = fmaxf(v1[j], 0.f); v1[j] *= v1[j]; }
                    u32x4 w; w.x = cvt_pk_bf16(v0[0], v0[1]); w.y = cvt_pk_bf16(v0[2], v0[3]); w.z = cvt_pk_bf16(v1[0], v1[1]); w.w = cvt_pk_bf16(v1[2], v1[3]);
                    *(u32x4*)(O + (size_t)(row0 + ai * 128 + m * 16) * 4096 + col0 + bj * 128) = w; } }
    }
};

constexpr int PH_PER_GROUP = 11, N_PHASES = 1 + NGRP * PH_PER_GROUP;
typedef const __attribute__((address_space(4))) Params* CParamsPtr;
constexpr size_t OFF_BAR = 900096;
static_assert(OFF_BAR >= 33 * 6144 * 4 && OFF_BAR + 3456 * 4 <= OFF_WA, "barrier word placement");
#define XB_TMO      128
#define XB_XCNT(j)  (256  + 64 * (j))
#define XB_XSUB(j)  (1280 + 64 * (j))
#define XB_XGEN(j)  (2304 + 64 * (j))
#define XB_TOP      3328
#define XB_TOPGEN   3392
#define XCD_BAR_WORDS 3456
#define XB_SPIN_CAP (1u << 22)
__device__ __forceinline__ unsigned xb_ld(unsigned* p)              { return __hip_atomic_load(p, __ATOMIC_RELAXED, __HIP_MEMORY_SCOPE_AGENT); }
__device__ __forceinline__ unsigned xb_add(unsigned* p, unsigned v) { return __hip_atomic_fetch_add(p, v, __ATOMIC_RELAXED, __HIP_MEMORY_SCOPE_AGENT); }
__device__ __forceinline__ unsigned xb_xcc_id() { return (unsigned)__builtin_amdgcn_s_getreg((3 << 11) | 20) & 0xFu; }
#define XB_SPIN(cond, bar) do { unsigned _sp = 0; while (cond) { __builtin_amdgcn_s_sleep(1); \
    if ((++_sp & 255u) == 0u) { if (xb_ld(&(bar)[XB_TMO])) break; if (_sp > XB_SPIN_CAP) { atomicAdd(&(bar)[XB_TMO], 1u); break; } } } } while (0)
__device__ __forceinline__ void xcd_barrier_complete(unsigned* bar, unsigned x, unsigned G, unsigned& nloc, unsigned& nx) {
    unsigned sum, cnt, mine, sp = 0u;
    for (;;) {
        sum = 0u; cnt = 0u; mine = 0u;
#pragma unroll
        for (unsigned j = 0; j < 16; ++j) { const unsigned c = xb_ld(&bar[XB_XCNT(j)]); sum += c; cnt += (c > 0u) ? 1u : 0u; mine = (j == x) ? c : mine; }
        if (sum == G) break;
        __builtin_amdgcn_s_sleep(1);
        if ((++sp & 255u) == 0u) { if (xb_ld(&bar[XB_TMO])) break; if (sp > XB_SPIN_CAP) { atomicAdd(&bar[XB_TMO], 1u); break; } }
    }
    nloc = mine > 0u ? mine : 1u; nx = cnt > 0u ? cnt : 1u;
}
__device__ __forceinline__ void grid_bar(unsigned* bar, volatile LAS unsigned* st, unsigned G, int tid) {
    asm volatile("s_waitcnt vmcnt(0)" ::: "memory");
    __syncthreads();
    if (tid == 0) {
        __builtin_amdgcn_s_waitcnt(0);
        const unsigned x = xb_xcc_id();
        unsigned nloc = st[0], nx = st[1];
        if (nloc == 0u) { xcd_barrier_complete(bar, x, G, nloc, nx); st[0] = nloc; st[1] = nx; }
        const unsigned old = xb_add(&bar[XB_XSUB(x)], 1u);
        const unsigned gen = old / nloc;
        if (old + 1u == (gen + 1u) * nloc) {
            __builtin_amdgcn_fence(__ATOMIC_RELEASE, "agent");
            asm volatile("s_waitcnt vmcnt(0)" ::: "memory");
            const unsigned og = xb_add(&bar[XB_TOP], 1u);
            const unsigned tg = og / nx;
            if (og + 1u == (tg + 1u) * nx) xb_add(&bar[XB_TOPGEN], 1u);
            else XB_SPIN(xb_ld(&bar[XB_TOPGEN]) == tg, bar);
            __builtin_amdgcn_fence(__ATOMIC_ACQUIRE, "agent");
            xb_add(&bar[XB_XGEN(x)], 1u);
            asm volatile("s_waitcnt vmcnt(0)" ::: "memory");
        } else {
            XB_SPIN(xb_ld(&bar[XB_XGEN(x)]) == gen, bar);
            __builtin_amdgcn_fence(__ATOMIC_ACQUIRE, "agent");
            asm volatile("s_waitcnt vmcnt(0)" ::: "memory");
        }
    }
    __syncthreads();
}
constexpr int ST_OFF = LDS_BYTES - 16;
__global__ void __launch_bounds__(512) mega(Params p_arg) {
    extern __shared__ __attribute__((aligned(16))) unsigned char lds_raw[];
    LAS unsigned char* lds = (LAS unsigned char*)lds_raw;
    if (threadIdx.x == 0) { volatile LAS unsigned* st = (volatile LAS unsigned*)(lds + ST_OFF); st[0] = 0u; st[1] = 0u; (void)xb_add(&((unsigned*)(p_arg.ws + OFF_BAR))[XB_XCNT(xb_xcc_id())], 1u); }
    const int wave0 = __builtin_amdgcn_readfirstlane(threadIdx.x >> 6);
    {
        const int tid = threadIdx.x, wid = wave0, lane = tid & 63;
        phase_p0(p_arg, lds, blockIdx.x, gridDim.x, tid, wid, lane);
    }
    if (p_arg.ws == nullptr) cg::this_grid().sync();
    grid_bar((unsigned*)(p_arg.ws + OFF_BAR), (volatile LAS unsigned*)(lds + ST_OFF), (unsigned)gridDim.x, (int)threadIdx.x);
#ifndef REPEAT_Q
#define REPEAT_Q -1
#endif
    for (int ph = 1; ph < N_PHASES; ++ph) {
        for (int rep = 0; rep < (((ph - 1) % PH_PER_GROUP == REPEAT_Q) ? 2 : 1); ++rep) {
        if ((ph - 1) % PH_PER_GROUP == 0 && ph > 1) continue;
        int wv_ = wave0, wg_ = blockIdx.x; asm volatile("" : "+s"(wv_), "+s"(wg_));
        int lane_; asm volatile("v_mbcnt_lo_u32_b32 %0, -1, 0\n\tv_mbcnt_hi_u32_b32 %0, -1, %0" : "=v"(lane_));
        int tid_ = wv_ * 64 + lane_;
        const int tid = tid_, wid = wv_, lane = tid & 63;
        const int wg = wg_, G = gridDim.x;
        const int gw = wg * 8 + wid, NGW = G * 8;
        pg8::StaticOrder S;
#if defined(__HIP_DEVICE_COMPILE__)
        CParamsPtr gp = (CParamsPtr)__builtin_amdgcn_kernarg_segment_ptr();
        asm volatile("" : "+s"(gp) :: "memory");
        const Params p = *gp;
#else
        const Params p = p_arg;
#endif
        if (ph > 1 || rep > 0) grid_bar((unsigned*)(p.ws + OFF_BAR), (volatile LAS unsigned*)(lds + ST_OFF), (unsigned)G, tid);
#ifdef EXTRA_BARRIERS
        for (int xb = 0; xb < EXTRA_BARRIERS; ++xb) grid_bar((unsigned*)(p.ws + OFF_BAR), (volatile LAS unsigned*)(lds + ST_OFF), (unsigned)G, tid);
#endif
        const int g = (ph - 1) / PH_PER_GROUP, q = (ph - 1) % PH_PER_GROUP;
        unsigned char* ws = p.ws;
        const float* mod = (const float*)(ws + OFF_MOD);
        switch (q) {
        case 0: phase_ln0(p, g, gw, NGW, lane); break;
        case 1: { pg8::Gemm gm{(const bf16_t*)(ws + OFF_H0), (const bf16_t*)(ws + OFF_WA), RG, NA, 1024}; S.init(RG, NA, G, wg);
                  EpiRaw E{(bf16_t*)(ws + OFF_RAW), NA}; pg8::gemm_phase(lds, gm, S, E, tid); } break;
        case 2: phase_conv(p, lds, wg, G, tid); break;
        case 3: {
#ifdef PROBE_SSD
            for (int item = wg; item < BG * 8 * 2; item += G) { if (item & 1) ssd_item<1, PROBE_SSD>(p, item >> 1, lds, wid, lane); else ssd_item<0, PROBE_SSD>(p, item >> 1, lds, wid, lane); }
#endif
            for (int item = wg; item < BG * 8 * 2; item += G) { if (item & 1) ssd_item<1>(p, item >> 1, lds, wid, lane); else ssd_item<0>(p, item >> 1, lds, wid, lane); }
            int l2; asm volatile("v_mbcnt_lo_u32_b32 %0, -1, 0\n\tv_mbcnt_hi_u32_b32 %0, -1, %0" : "=v"(l2));
            int t2 = wv_ * 64 + l2;
            const int wid2 = wv_, lane2 = t2 & 63;
            if (wid2 < 4) for (int cu = wg; cu < BG * 8 * 2; cu += G) { const int it = (cu >> 1) * 4 + wid2; if (cu & 1) lru_item<1>(p, it, lane2); else lru_item<0>(p, it, lane2); }
        } break;
        case 4: { pg8::Gemm gm{(const bf16_t*)(ws + OFF_H0) + (size_t)CGR * 1024, (const bf16_t*)(ws + OFF_WB), TG, NBC, 1024}; S.init(TG, NBC, G, wg);
                  EpiG1b E{(bf16_t*)(ws + OFF_Y1), (const bf16_t*)(ws + OFF_Y2), (bf16_t*)(ws + OFF_YLF), (const bf16_t*)(ws + OFF_YLB), (bf16_t*)(ws + OFF_GATES), p.b_gate, (LAS float*)(lds + XCH_OFF)};
                  pg8::gemm_phase(lds, gm, S, E, tid); } break;
        case 5: { S.init(TG, 1024, G, wg);
                  { pg8::Gemm gm{(const bf16_t*)(ws + OFF_Y1), (const bf16_t*)(ws + OFF_WBRS), TG, 1024, 2048};
                    EpiBrS E{(const bf16_t*)(ws + OFF_GATES), (bf16_t*)(ws + OFF_TMP)}; pg8::gemm_phase(lds, gm, S, E, tid); }
                  { pg8::Gemm gm{(const bf16_t*)(ws + OFF_YLF), (const bf16_t*)(ws + OFF_WBRL), TG, 1024, 1024};
                    EpiBrL E{(const bf16_t*)(ws + OFF_GATES), (const bf16_t*)(ws + OFF_TMP), (bf16_t*)(ws + OFF_MERGED)}; pg8::gemm_phase(lds, gm, S, E, tid); } } break;
        case 6: { pg8::Gemm gm{(const bf16_t*)(ws + OFF_MERGED), (const bf16_t*)(ws + OFF_WOUT), TG, 1024, 1024}; S.init(TG, 1024, G, wg);
                  EpiRes E{mod + 2 * DM, nullptr, (bf16_t*)(ws + OFF_BR1), g * BG}; pg8::gemm_phase(lds, gm, S, E, tid); } break;
        case 7: phase_ln1(p, g, gw, NGW, lane); break;
        case 8: { pg8::Gemm gm{(const bf16_t*)(ws + OFF_H1), (const bf16_t*)(ws + OFF_W1), TG, 4096, 1024}; S.init(TG, 4096, G, wg);
                  EpiMlp1 E{(bf16_t*)(ws + OFF_HID), p.b_mlp1}; pg8::gemm_phase(lds, gm, S, E, tid); } break;
        case 9: { pg8::Gemm gm{(const bf16_t*)(ws + OFF_HID), (const bf16_t*)(ws + OFF_W2), TG, 1024, 4096}; S.init(TG, 1024, G, wg);
                  EpiRes E{mod + 5 * DM, p.b_mlp2, (bf16_t*)(ws + OFF_BR2), g * BG}; pg8::gemm_phase(lds, gm, S, E, tid); } break;
        case 10: phase_ln2(p, g, gw, NGW, lane); if (g + 1 < NGRP) phase_ln0(p, g + 1, gw, NGW, lane); break;
        }
        }
    }
}

extern "C" void kernel_launch(void* const* d_in, const int* in_sizes, int n_in, void* d_out, int out_size, void* d_ws, size_t ws_size, hipStream_t stream) {
    static int grid = 0;
    if (grid == 0) {
        if (n_in != 32 || ws_size < WS_END) { fprintf(stderr, "kernel_launch: unexpected n_in %d / ws_size %zu (need %zu)\n", n_in, ws_size, (size_t)WS_END); grid = -1; return; }
        if (hipFuncSetAttribute((const void*)mega, hipFuncAttributeMaxDynamicSharedMemorySize, LDS_BYTES) != hipSuccess) { fprintf(stderr, "kernel_launch: hipFuncSetAttribute failed\n"); grid = -1; return; }
        int dev = 0, cus = 0, per_cu = 0;
        hipGetDevice(&dev); hipDeviceGetAttribute(&cus, hipDeviceAttributeMultiprocessorCount, dev);
        hipOccupancyMaxActiveBlocksPerMultiprocessor(&per_cu, (const void*)mega, 512, LDS_BYTES);
        if (per_cu < 1) { fprintf(stderr, "kernel_launch: occupancy query says %d blocks per CU\n", per_cu); per_cu = 1; }
        (void)hipGetLastError();
        grid = cus;
    }
    if (grid < 0) return;
    Params p{};
    const float** pp = (const float**)&p;
    for (int i = 0; i < 32; ++i) pp[i] = (const float*)d_in[i];
    p.out = (float*)d_out; p.ws = (unsigned char*)d_ws;
    if (hipMemsetAsync((unsigned char*)d_ws + OFF_BAR, 0, XCD_BAR_WORDS * 4, stream) != hipSuccess) { fprintf(stderr, "kernel_launch: memset of the barrier word failed\n"); return; }
    void* args[] = {&p};
    hipError_t e = hipLaunchCooperativeKernel((const void*)mega, dim3(grid), dim3(512), args, LDS_BYTES, stream);
    if (e != hipSuccess) fprintf(stderr, "kernel_launch: cooperative launch failed: %s (grid %d)\n", hipGetErrorString(e), grid);
}
```
